# Optimizing an MI355X kernel written in HIP

```python
import math
import jax, jax.numpy as jnp
from jax import lax
import numpy as np

D_MODEL = 1024
BATCH = 8
SEQ = 2048
DEPTH = 2

GRID_W = 64
ROPE_THETA = 10000.0
HEAD_DIM = 64
ATT_Q_HEADS = 8
ATT_KV_HEADS = 2
Q_BLOCK = 128
ATT_Q_W = ATT_Q_HEADS * HEAD_DIM
ATT_KV_W = ATT_KV_HEADS * HEAD_DIM
HY_WIDTH = 512
HY_ORDER = 2
HY_BANDS = 16
HY_EMB = 1 + 2 * HY_BANDS
HY_FFN = 64
HY_FAST_DECAY = 0.3
HY_SLOW_DECAY = 1.5
HY_TARGET = 1e-2
GLA_HEADS = 4
GLA_DK = 64
GLA_DV = 128
GLA_RANK = 16
GLA_NORMALIZER = 16.0
GLA_CHUNK = 64
GLA_K_W = GLA_HEADS * GLA_DK
GLA_V_W = GLA_HEADS * GLA_DV
MEM_LEN = 256
X_HEADS = 4
X_HEAD_DIM = D_MODEL // X_HEADS
D_FF = 4 * D_MODEL
N_BRANCH = 3
EPS = 1e-6
IN_SPLITS = (ATT_Q_W, ATT_KV_W, ATT_KV_W, 3 * HY_WIDTH, GLA_K_W, GLA_K_W, GLA_V_W, GLA_V_W,
             2 * GLA_RANK, N_BRANCH * D_MODEL)
N_IN = ATT_Q_W + 2 * ATT_KV_W + 3 * HY_WIDTH + 2 * GLA_K_W + 2 * GLA_V_W + 2 * GLA_RANK + N_BRANCH * D_MODEL

kernel_name = "hybrid_gqa_hyena_gla_gated_encoder"

F32 = jnp.float32


def rmsnorm(x, g):
    xf = x.astype(F32)
    y = xf * lax.rsqrt(jnp.mean(xf * xf, axis=-1, keepdims=True) + EPS)
    return (y * g.astype(F32)).astype(x.dtype)


def split_cols(u, sizes):
    idx = [int(i) for i in np.cumsum(sizes)[:-1]]
    return jnp.split(u, idx, axis=-1)


def axial_rope_angles(L):
    rows = L // GRID_W
    r, c = jnp.meshgrid(jnp.arange(rows), jnp.arange(GRID_W), indexing="ij")
    n_freq = HEAD_DIM // 4
    inv = ROPE_THETA ** (-jnp.arange(n_freq, dtype=F32) / n_freq)
    pos = jnp.stack([r.reshape(-1), c.reshape(-1)], axis=1).astype(F32)
    ang = pos[:, :, None] * inv
    return jnp.cos(ang), jnp.sin(ang)


def apply_rope(x, cos, sin):
    xs = x.reshape(x.shape[:-1] + (2, 2, HEAD_DIM // 4)).astype(F32)
    x1, x2 = xs[..., 0, :], xs[..., 1, :]
    out = jnp.stack([x1 * cos - x2 * sin, x1 * sin + x2 * cos], axis=-2)
    return out.reshape(x.shape).astype(x.dtype)


def attention_mixer(q, k, v, qn, kn, cos, sin):
    B, L, _ = q.shape
    G = ATT_Q_HEADS // ATT_KV_HEADS
    q = rmsnorm(q.reshape(B, L, ATT_Q_HEADS, HEAD_DIM), qn).transpose(0, 2, 1, 3)
    k = rmsnorm(k.reshape(B, L, ATT_KV_HEADS, HEAD_DIM), kn).transpose(0, 2, 1, 3)
    v = v.reshape(B, L, ATT_KV_HEADS, HEAD_DIM).transpose(0, 2, 1, 3)
    q = apply_rope(q, cos, sin).reshape(B, ATT_KV_HEADS, G, L, HEAD_DIM)
    k = apply_rope(k, cos, sin)
    nb = L // Q_BLOCK
    qb = jnp.moveaxis(q.reshape(B, ATT_KV_HEADS, G, nb, Q_BLOCK, HEAD_DIM), 3, 0)
    scale = HEAD_DIM ** -0.5

    def block(qblk):
        s = jnp.einsum("bkgqd,bktd->bkgqt", qblk, k).astype(F32) * scale
        p = jax.nn.softmax(s, axis=-1).astype(v.dtype)
        return jnp.einsum("bkgqt,bktd->bkgqd", p, v)

    o = lax.map(block, qb)
    o = jnp.moveaxis(o, 0, 3).reshape(B, ATT_Q_HEADS, L, HEAD_DIM)
    return o.transpose(0, 2, 1, 3).reshape(B, L, ATT_Q_W)


def short_conv(u, w):
    up = jnp.pad(u, ((0, 0), (1, 1), (0, 0)))
    return up[:, :-2] * w[0] + up[:, 1:-1] * w[1] + up[:, 2:] * w[2]


def hyena_pos_features(L):
    t = jnp.arange(L, dtype=F32)
    t_norm = t / max(L - 1, 1)
    w = 2.0 * math.pi * t / L
    f = jnp.linspace(1e-4, HY_BANDS - 1, HY_BANDS, dtype=F32)
    fw = w[:, None] * f
    z = jnp.concatenate([t_norm[:, None], jnp.cos(fw), -jnp.sin(fw)], axis=-1)
    deltas = jnp.abs(jnp.linspace(math.log(HY_TARGET) / HY_FAST_DECAY,
                                  math.log(HY_TARGET) / HY_SLOW_DECAY, HY_WIDTH, dtype=F32))
    window = jnp.exp(-t_norm[:, None] * deltas)
    return z, window


def hyena_filter_spectra(z, window, w1, b1, w2, b2, w3, b3, freq):
    L = z.shape[0]
    c = lambda a: a.astype(F32)
    h = jnp.sin(c(freq[0]) * (z @ c(w1) + c(b1)))
    h = jnp.sin(c(freq[1]) * (h @ c(w2) + c(b2)))
    h = (h @ c(w3) + c(b3)).reshape(L, HY_ORDER, 2, HY_WIDTH) * window[:, None, None, :]
    fwd, bwd = h[:, :, 0], h[:, :, 1]
    f = jnp.concatenate([fwd, jnp.zeros((1, HY_ORDER, HY_WIDTH), F32), bwd[1:][::-1]], axis=0)
    f = f / (jnp.sum(jnp.abs(f), axis=0, keepdims=True) + EPS)
    return jnp.fft.rfft(f, axis=0)


def long_conv(u, spec, skip):
    L = u.shape[1]
    uf = u.astype(F32)
    y = jnp.fft.irfft(jnp.fft.rfft(uf, n=2 * L, axis=1) * spec, n=2 * L, axis=1)[:, :L]
    return (y + uf * skip.astype(F32)).astype(u.dtype)


def hyena_mixer(u, conv_w, spec, skip):
    u = short_conv(u, conv_w)
    v, x1, x2 = jnp.split(u, 3, axis=-1)
    z = x1 * long_conv(v, spec[:, 0], skip[0])
    return x2 * long_conv(z, spec[:, 1], skip[1])


def gla_scan(q, k, v, g, include_diag):
    B, H, L, dk = q.shape
    dv = v.shape[-1]
    C = GLA_CHUNK
    N = L // C
    q, k, g = (a.reshape(B, H, N, C, dk) for a in (q, k, g))
    v = v.reshape(B, H, N, C, dv)
    b = jnp.cumsum(g, axis=3)
    b_last = b[:, :, :, -1:, :]
    q_dec = q * jnp.exp(b)
    a = jnp.einsum("bhncd,bhnsd->bhncs", q_dec, k * jnp.exp(-b))
    mask = jnp.tril(jnp.ones((C, C), dtype=bool), k=0 if include_diag else -1)
    o = jnp.einsum("bhncs,bhnse->bhnce", jnp.where(mask, a, 0.0), v)
    d_state = jnp.einsum("bhncd,bhnce->bhnde", k * jnp.exp(b_last - b), v)
    decay = jnp.exp(b_last[:, :, :, 0, :])

    def step(S, inp):
        dec, ds = inp
        return dec[..., None] * S + ds, S

    _, s_prev = lax.scan(step, jnp.zeros((B, H, dk, dv), F32),
                         (jnp.moveaxis(decay, 2, 0), jnp.moveaxis(d_state, 2, 0)))
    s_prev = jnp.moveaxis(s_prev, 0, 2)
    o = o + jnp.einsum("bhncd,bhnde->bhnce", q_dec, s_prev)
    return o.reshape(B, H, L, dv)


def gla_mixer(q, k, v, og, lr, w_lr, b_lr, onorm):
    B, L, _ = q.shape
    heads = lambda a, d: a.astype(F32).reshape(B, L, GLA_HEADS, d).transpose(0, 2, 1, 3)
    q = heads(q, GLA_DK) * (GLA_DK ** -0.5)
    k = heads(k, GLA_DK)
    v = heads(v, GLA_DV)
    logit = jnp.einsum("btsr,srd->btsd", lr.astype(F32).reshape(B, L, 2, GLA_RANK),
                       w_lr.astype(F32)) + b_lr.astype(F32)
    g = jax.nn.log_sigmoid(logit) / GLA_NORMALIZER
    g_f = heads(g[:, :, 0], GLA_DK)
    g_b = heads(g[:, :, 1], GLA_DK)
    fl = lambda a: jnp.flip(a, axis=2)
    o_f = gla_scan(q, k, v, g_f, True)
    o_b = fl(gla_scan(fl(q), fl(k), fl(v), fl(g_b), False))
    o = (o_f + o_b).transpose(0, 2, 1, 3)
    o = rmsnorm(o, onorm) * jax.nn.silu(og.astype(F32).reshape(B, L, GLA_HEADS, GLA_DV))
    return o.reshape(B, L, GLA_V_W).astype(og.dtype)


def memory_cross_attention(hn, mn, wq, wk, wv, wo, qn, kn):
    B, L, _ = hn.shape
    M = mn.shape[1]
    q = rmsnorm((hn @ wq).reshape(B, L, X_HEADS, X_HEAD_DIM), qn)
    k = rmsnorm((mn @ wk).reshape(B, M, X_HEADS, X_HEAD_DIM), kn)
    v = (mn @ wv).reshape(B, M, X_HEADS, X_HEAD_DIM)
    s = jnp.einsum("blhd,bmhd->bhlm", q, k).astype(F32) * (X_HEAD_DIM ** -0.5)
    p = jax.nn.softmax(s, axis=-1).astype(v.dtype)
    o = jnp.einsum("bhlm,bmhd->blhd", p, v).reshape(B, L, D_MODEL)
    return o @ wo


def setup_inputs(seed: int = 0) -> dict:
    key = jax.random.key(seed)
    ks = iter(jax.random.split(key, 40))

    def nrm(shape, s):
        return jax.random.normal(next(ks), shape, F32) * s

    def gain(shape):
        return 1.0 + nrm(shape, 0.02)

    Ld = DEPTH
    return {
        "x": nrm((BATCH, SEQ, D_MODEL), 1.0),
        "mem": nrm((BATCH, MEM_LEN, D_MODEL), 1.0),
        "ln_mix": gain((Ld, D_MODEL)),
        "w_in": nrm((Ld, D_MODEL, N_IN), D_MODEL ** -0.5),
        "attn_qnorm": gain((Ld, HEAD_DIM)),
        "attn_knorm": gain((Ld, HEAD_DIM)),
        "hy_conv": nrm((Ld, 3, 3 * HY_WIDTH), 3 ** -0.5),
        "hy_w1": nrm((Ld, HY_EMB, HY_FFN), HY_EMB ** -0.5),
        "hy_b1": nrm((Ld, HY_FFN), 0.1),
        "hy_w2": nrm((Ld, HY_FFN, HY_FFN), HY_FFN ** -0.5),
        "hy_b2": nrm((Ld, HY_FFN), 0.1),
        "hy_w3": nrm((Ld, HY_FFN, HY_ORDER * 2 * HY_WIDTH), HY_FFN ** -0.5),
        "hy_b3": nrm((Ld, HY_ORDER * 2 * HY_WIDTH), 0.1),
        "hy_freq": 1.0 + nrm((Ld, 2, HY_FFN), 0.1),
        "hy_skip": nrm((Ld, HY_ORDER, HY_WIDTH), 0.5),
        "gla_w_lr": nrm((Ld, 2, GLA_RANK, GLA_K_W), GLA_RANK ** -0.5),
        "gla_b_lr": nrm((Ld, 2, GLA_K_W), 0.1),
        "gla_onorm": gain((Ld, GLA_DV)),
        "w_br_attn": nrm((Ld, ATT_Q_W, D_MODEL), ATT_Q_W ** -0.5),
        "w_br_hyena": nrm((Ld, HY_WIDTH, D_MODEL), HY_WIDTH ** -0.5),
        "w_br_gla": nrm((Ld, GLA_V_W, D_MODEL), GLA_V_W ** -0.5),
        "w_out": nrm((Ld, D_MODEL, D_MODEL), D_MODEL ** -0.5),
        "ln_x": gain((Ld, D_MODEL)),
        "ln_mem": gain((Ld, D_MODEL)),
        "x_wq": nrm((Ld, D_MODEL, D_MODEL), D_MODEL ** -0.5),
        "x_wk": nrm((Ld, D_MODEL, D_MODEL), D_MODEL ** -0.5),
        "x_wv": nrm((Ld, D_MODEL, D_MODEL), D_MODEL ** -0.5),
        "x_wo": nrm((Ld, D_MODEL, D_MODEL), D_MODEL ** -0.5),
        "x_qnorm": gain((Ld, X_HEAD_DIM)),
        "x_knorm": gain((Ld, X_HEAD_DIM)),
        "ln_mlp": gain((Ld, D_MODEL)),
        "mlp_w1": nrm((Ld, D_MODEL, D_FF), D_MODEL ** -0.5),
        "mlp_w2": nrm((Ld, D_FF, D_MODEL), D_FF ** -0.5),
    }


def reference(x, mem, ln_mix, w_in, attn_qnorm, attn_knorm, hy_conv, hy_w1, hy_b1, hy_w2, hy_b2,
              hy_w3, hy_b3, hy_freq, hy_skip, gla_w_lr, gla_b_lr, gla_onorm, w_br_attn, w_br_hyena,
              w_br_gla, w_out, ln_x, ln_mem, x_wq, x_wk, x_wv, x_wo, x_qnorm, x_knorm, ln_mlp,
              mlp_w1, mlp_w2):
    B, L, _ = x.shape
    cos, sin = axial_rope_angles(L)
    z_pos, window = hyena_pos_features(L)
    h = x
    for i in range(DEPTH):
        hn = rmsnorm(h, ln_mix[i])
        (aq, ak, av, hy, gq, gk, gv, go, glr, gates) = split_cols(hn @ w_in[i], IN_SPLITS)
        y_a = attention_mixer(aq, ak, av, attn_qnorm[i], attn_knorm[i], cos, sin) @ w_br_attn[i]
        spec = hyena_filter_spectra(z_pos, window, hy_w1[i], hy_b1[i], hy_w2[i], hy_b2[i],
                                    hy_w3[i], hy_b3[i], hy_freq[i])
        y_b = hyena_mixer(hy, hy_conv[i], spec, hy_skip[i]) @ w_br_hyena[i]
        y_c = gla_mixer(gq, gk, gv, go, glr, gla_w_lr[i], gla_b_lr[i], gla_onorm[i]) @ w_br_gla[i]
        gate = jax.nn.sigmoid(gates.reshape(B, L, N_BRANCH, D_MODEL))
        mixed = gate[:, :, 0] * y_a + gate[:, :, 1] * y_b + gate[:, :, 2] * y_c
        h = h + mixed @ w_out[i]
        h = h + memory_cross_attention(rmsnorm(h, ln_x[i]), rmsnorm(mem, ln_mem[i]),
                                       x_wq[i], x_wk[i], x_wv[i], x_wo[i], x_qnorm[i], x_knorm[i])
        hn = rmsnorm(h, ln_mlp[i])
        h = h + jnp.square(jax.nn.relu(hn @ mlp_w1[i])) @ mlp_w2[i]
    return h
```

```cpp
#include <hip/hip_runtime.h>
#include <hip/hip_cooperative_groups.h>
#include <cstdio>
namespace cg = cooperative_groups;

typedef __attribute__((ext_vector_type(8))) short bf16x8;
typedef __attribute__((ext_vector_type(4))) float f32x4;
typedef __attribute__((ext_vector_type(16))) float f32x16;
typedef unsigned short bf16_t;

#define DI __device__ __forceinline__
#ifndef NI
#define NI __device__ __forceinline__
#endif

constexpr int NT = 256;
constexpr int SEQ = 2048;
constexpr int TOK = 16384;
constexpr int NIN = 6944;
constexpr size_t MiB = 1ull << 20;

constexpr size_t OFF_SPEC = 0;
constexpr size_t OFF_PART = 17 * MiB;
constexpr size_t OFF_DECAY = 18 * MiB;
constexpr size_t OFF_H2 = 18 * MiB + 512 * 1024;
constexpr size_t OFF_TW = 19 * MiB + 512 * 1024;
constexpr size_t OFF_ROPE = OFF_TW + 32 * 1024;
constexpr size_t OFF_RMEM = OFF_ROPE + 8 * 1024;
constexpr size_t OFF_PROBE = OFF_RMEM + 8 * 1024;
constexpr size_t OFF_MEMK = 20 * MiB;
constexpr size_t OFF_MEMVT = 24 * MiB;
constexpr size_t OFF_BAR = 28 * MiB;
constexpr size_t OFF_Q = 29 * MiB;
constexpr size_t OFF_OA = OFF_Q;
constexpr size_t OFF_K = 45 * MiB;
constexpr size_t OFF_VT = 49 * MiB;
constexpr size_t OFF_HYT = 53 * MiB;
constexpr size_t OFF_GQ = 101 * MiB;
constexpr size_t OFF_GK = 109 * MiB;
constexpr size_t OFF_GV = 117 * MiB;
constexpr size_t OFF_GO = 133 * MiB;
constexpr size_t OFF_GLR = 149 * MiB;
constexpr size_t OFF_GST = 151 * MiB;
constexpr size_t OFF_MIXED = 151 * MiB;
constexpr size_t OFF_HB = 183 * MiB;
constexpr size_t OFF_WB = 215 * MiB;
constexpr size_t OFF_XQ = 29 * MiB;
constexpr size_t OFF_XO = 61 * MiB;
constexpr size_t OFF_HID = 29 * MiB;
constexpr size_t WS_WIN = 7110656;
constexpr size_t WS_W2L1 = 2 * WS_WIN;
constexpr size_t WO_WOUT = 0;
constexpr size_t WO_WQ = 1048576;
constexpr size_t WO_W1 = 2097152;
constexpr size_t WO_W2 = 6291456;
constexpr size_t WO_WK = 10485760;
constexpr size_t WO_WV = WO_WK + 1048576;
constexpr size_t WO_WO = WO_WV + 1048576;
constexpr size_t WO_BR = WO_WO + 1048576;
constexpr size_t WO_LAYER = WO_BR + 1572864;
constexpr int NWL = 128 + 128 + 512 + 512 + 128 * 3 + 192;
constexpr int NWCONV = 2 * 880 + 2 * NWL;

struct Params {
  const float* in[33];
  float* out;
  unsigned char* ws;
};
typedef const __attribute__((address_space(4))) Params& PRef;
typedef const __attribute__((address_space(4))) Params* PPtr;
__device__ __forceinline__ PPtr launder_p(PPtr p) { asm volatile("" : "+s"(p)); return p; }

DI int opaque_tid() { int t = threadIdx.x; asm volatile("" : "+v"(t)); return t; }
typedef __bf16 bf2_t __attribute__((ext_vector_type(2)));
typedef float f2_t __attribute__((ext_vector_type(2)));
DI unsigned f2bf(float f) { __bf16 h = (__bf16)f; return (unsigned)__builtin_bit_cast(unsigned short, h); }
DI float bf2f(unsigned h) { return __uint_as_float(h << 16); }
DI unsigned pk2(float a, float b) { f2_t v = {a, b}; return __builtin_bit_cast(unsigned, __builtin_convertvector(v, bf2_t)); }
DI float bflo(unsigned u) { return __uint_as_float(u << 16); }
DI float bfhi(unsigned u) { return __uint_as_float(u & 0xffff0000u); }
DI float sigmoidf_(float x) { return 1.f / (1.f + __expf(-x)); }

DI float row_rstd(const float* partial, int m) {
  const float4* p = (const float4*)(partial + (size_t)m * 16);
  float4 a = p[0], b = p[1], c = p[2], d = p[3];
  float s = a.x + a.y + a.z + a.w + b.x + b.y + b.z + b.w + c.x + c.y + c.z + c.w + d.x + d.y + d.z + d.w;
  return rsqrtf(s * (1.f / 1024.f) + 1e-6f);
}

DI int swz_off(int row, int k) {
  int st = (row >> 4) * 2 + (k >> 5);
  int ob = (row & 15) * 64 + (k & 31) * 2;
  return (st * 1024 + (ob ^ (((ob >> 9) & 1) << 5))) >> 1;
}
DI int lds_off(bool swz, int row, int k) { return swz ? swz_off(row, k) : row * 72 + k; }

template <int ROWS, bool SWZ = true> struct LdRowF32 {
  static constexpr int NV = ROWS / 16;
  const float* p; int ld; const float* gain; int tid; f32x4 r[NV];
  DI void load(int k0) {
    int c4 = tid & 15, r0 = tid >> 4;
    f32x4 g = (f32x4){1.f, 1.f, 1.f, 1.f};
    if (gain) g = *(const f32x4*)(gain + k0 + c4 * 4);
#pragma unroll
    for (int i = 0; i < NV; i++) {
      f32x4 v = *(const f32x4*)(p + (unsigned)((r0 + 16 * i) * ld + k0 + c4 * 4));
      r[i] = v * g;
    }
  }
  DI void store(bf16_t* s) {
    int c4 = tid & 15, r0 = tid >> 4;
#pragma unroll
    for (int i = 0; i < NV; i++)
      *(uint2*)(s + lds_off(SWZ, r0 + 16 * i, c4 * 4)) = make_uint2(pk2(r[i][0], r[i][1]), pk2(r[i][2], r[i][3]));
  }
};

template <int ROWS, bool SWZ = true> struct LdRowBf16 {
  static constexpr int NV = ROWS / 32;
  const bf16_t* p; int ld; int tid; uint4 r[NV];
  DI void load(int k0) {
    int ch = tid & 7, r0 = tid >> 3;
#pragma unroll
    for (int i = 0; i < NV; i++) r[i] = *(const uint4*)(p + (unsigned)((r0 + 32 * i) * ld + k0 + ch * 8));
  }
  DI void store(bf16_t* s) {
    int ch = tid & 7, r0 = tid >> 3;
#pragma unroll
    for (int i = 0; i < NV; i++) *(uint4*)(s + lds_off(SWZ, r0 + 32 * i, ch * 8)) = r[i];
  }
};

template <int COLS, bool SWZ = true> struct LdKMajF32 {
  static constexpr int KPT = COLS / 16;
  static constexpr int KG = 64 / KPT;
  const float* p; int ld; int tid; const float* gain = nullptr; int ncol = COLS; f32x4 r[KPT];
  DI void load(int k0) {
    int kg = tid % KG, ng = tid / KG;
    int c0 = ng * 4 < ncol ? ng * 4 : 0;
#pragma unroll
    for (int i = 0; i < KPT; i++) {
      f32x4 v = *(const f32x4*)(p + (unsigned)((k0 + kg * KPT + i) * ld + c0));
      if (gain) v *= gain[k0 + kg * KPT + i];
      r[i] = v;
    }
  }
  DI void store(bf16_t* s) {
    int kg = tid % KG, ng = tid / KG;
#pragma unroll
    for (int c = 0; c < 4; c++) {
      if constexpr (KPT == 8) {
        uint4 v = make_uint4(pk2(r[0][c], r[1][c]), pk2(r[2][c], r[3][c]), pk2(r[4][c], r[5][c]), pk2(r[6][c], r[7][c]));
        *(uint4*)(s + lds_off(SWZ, ng * 4 + c, kg * 8)) = v;
      } else {
        uint2 v = make_uint2(pk2(r[0][c], r[1][c]), pk2(r[2][c], r[3][c]));
        *(uint2*)(s + lds_off(SWZ, ng * 4 + c, kg * 4)) = v;
      }
    }
  }
};

DI unsigned getbf(uint2 v, int c) { return c == 0 ? (v.x & 0xffffu) : c == 1 ? (v.x >> 16) : c == 2 ? (v.y & 0xffffu) : (v.y >> 16); }

template <int COLS, bool SWZ = true> struct LdKMajBf16 {
  static constexpr int KPT = COLS / 16;
  static constexpr int KG = 64 / KPT;
  const bf16_t* p; int ld; int tid; uint2 r[KPT];
  DI void load(int k0) {
    int kg = tid % KG, ng = tid / KG;
#pragma unroll
    for (int i = 0; i < KPT; i++) r[i] = *(const uint2*)(p + (unsigned)((k0 + kg * KPT + i) * ld + ng * 4));
  }
  DI void store(bf16_t* s) {
    int kg = tid % KG, ng = tid / KG;
#pragma unroll
    for (int c = 0; c < 4; c++) {
      if constexpr (KPT == 8) {
        uint4 v = make_uint4(getbf(r[0], c) | (getbf(r[1], c) << 16), getbf(r[2], c) | (getbf(r[3], c) << 16),
                             getbf(r[4], c) | (getbf(r[5], c) << 16), getbf(r[6], c) | (getbf(r[7], c) << 16));
        *(uint4*)(s + lds_off(SWZ, ng * 4 + c, kg * 8)) = v;
      } else {
        uint2 v = make_uint2(getbf(r[0], c) | (getbf(r[1], c) << 16), getbf(r[2], c) | (getbf(r[3], c) << 16));
        *(uint2*)(s + lds_off(SWZ, ng * 4 + c, kg * 4)) = v;
      }
    }
  }
};

template <int MI> DI void mma_step(const bf16_t* sW, const bf16_t* sA, f32x4 (&acc)[4][MI], int tid) {
  int lane = tid & 63, w = tid >> 6, r = lane & 15, q = lane >> 4;
  int wn = w >> 1, wm = w & 1;
  int lane_off = ((r * 64 + q * 16) ^ ((r >> 3) << 5)) >> 1;
  const bf16_t* pw = sW + wn * 4 * 1024 + lane_off;
  const bf16_t* pa = sA + wm * MI * 1024 + lane_off;
#pragma unroll
  for (int kk = 0; kk < 2; kk++) {
    bf16x8 a[4], b[MI];
#pragma unroll
    for (int ni = 0; ni < 4; ni++) a[ni] = *(const bf16x8*)(pw + (ni * 2 + kk) * 512);
#pragma unroll
    for (int mi = 0; mi < MI; mi++) b[mi] = *(const bf16x8*)(pa + (mi * 2 + kk) * 512);
#pragma unroll
    for (int ni = 0; ni < 4; ni++)
#pragma unroll
      for (int mi = 0; mi < MI; mi++) acc[ni][mi] = __builtin_amdgcn_mfma_f32_16x16x32_bf16(a[ni], b[mi], acc[ni][mi], 0, 0, 0);
  }
}

template <int MI> DI void mma_step_plain(const bf16_t* sW, const bf16_t* sA, f32x4 (&acc)[4][MI], int tid) {
  int lane = tid & 63, w = tid >> 6, r = lane & 15, q = lane >> 4;
  int wn = w >> 1, wm = w & 1;
#pragma unroll
  for (int kk = 0; kk < 2; kk++) {
    bf16x8 a[4], b[MI];
#pragma unroll
    for (int ni = 0; ni < 4; ni++) a[ni] = *(const bf16x8*)(sW + (wn * 64 + ni * 16 + r) * 72 + kk * 32 + q * 8);
#pragma unroll
    for (int mi = 0; mi < MI; mi++) b[mi] = *(const bf16x8*)(sA + (wm * 16 * MI + mi * 16 + r) * 72 + kk * 32 + q * 8);
#pragma unroll
    for (int ni = 0; ni < 4; ni++)
#pragma unroll
      for (int mi = 0; mi < MI; mi++) acc[ni][mi] = __builtin_amdgcn_mfma_f32_16x16x32_bf16(a[ni], b[mi], acc[ni][mi], 0, 0, 0);
  }
}
template <int MI, class LA, class LW> DI void gemm_kloop_plain(LA& la, LW& lw, int K, f32x4 (&acc)[4][MI], bf16_t* sW, bf16_t* sA) {
  la.load(0); lw.load(0);
  for (int k0 = 0; k0 < K; k0 += 64) {
    __syncthreads();
    la.store(sA); lw.store(sW);
    __syncthreads();
    if (k0 + 64 < K) { la.load(k0 + 64); lw.load(k0 + 64); }
    mma_step_plain<MI>(sW, sA, acc, la.tid);
  }
}
template <int MI, class LA, class LW> DI void gemm_kloop(LA& la, LW& lw, int K, f32x4 (&acc)[4][MI], bf16_t* sW, bf16_t* sA) {
  la.load(0); lw.load(0);
  for (int k0 = 0; k0 < K; k0 += 64) {
    __syncthreads();
    la.store(sA); lw.store(sW);
    __syncthreads();
    if (k0 + 64 < K) { la.load(k0 + 64); lw.load(k0 + 64); }
    mma_step<MI>(sW, sA, acc, la.tid);
  }
}

template <int MI, class LA, class LW> DI void gemm_kloop2(LA& la, LW& lw, int K, f32x4 (&acc)[4][MI], bf16_t* sW, bf16_t* sA) {
  LA la1 = la; LW lw1 = lw;
  la.load(0); lw.load(0);
  la1.load(64); lw1.load(64);
  for (int k0 = 0; k0 < K; k0 += 128) {
    __syncthreads();
    la.store(sA); lw.store(sW);
    __syncthreads();
    if (k0 + 128 < K) { la.load(k0 + 128); lw.load(k0 + 128); }
    mma_step<MI>(sW, sA, acc, la.tid);
    __syncthreads();
    la1.store(sA); lw1.store(sW);
    __syncthreads();
    if (k0 + 192 < K) { la1.load(k0 + 192); lw1.load(k0 + 192); }
    mma_step<MI>(sW, sA, acc, la.tid);
  }
}

template <int MI> DI void zero_acc(f32x4 (&acc)[4][MI]) {
#pragma unroll
  for (int a = 0; a < 4; a++)
#pragma unroll
    for (int b = 0; b < MI; b++) acc[a][b] = (f32x4){0.f, 0.f, 0.f, 0.f};
}

DI float2 cmul(float2 a, float2 b) { return make_float2(a.x * b.x - a.y * b.y, a.x * b.y + a.y * b.x); }
DI void fft_fill_twl(float2* twl, const float2* __restrict__ tw, int tid) {
#pragma unroll
  for (int i = 0; i < 4; i++) {
    int j = tid + 256 * i;
    float s, c; sincospif((float)j * (1.0f / 512.0f), &s, &c);
    twl[j] = make_float2(c, -s);
  }
  if (tid < 4) { float s, c; sincospif((float)tid * (1.0f / 2048.0f), &s, &c); twl[1024 + tid] = make_float2(c, -s); }
}
DI int bi(int x) { return x + (x >> 4); }
DI void dft4(float2 x0, float2 x1, float2 x2, float2 x3, float2& y0, float2& y1, float2& y2, float2& y3) {
  float2 v0 = make_float2(x0.x + x2.x, x0.y + x2.y), v1 = make_float2(x0.x - x2.x, x0.y - x2.y);
  float2 v2 = make_float2(x1.x + x3.x, x1.y + x3.y), dd = make_float2(x1.x - x3.x, x1.y - x3.y);
  float2 v3 = make_float2(dd.y, -dd.x);
  y0 = make_float2(v0.x + v2.x, v0.y + v2.y);
  y1 = make_float2(v1.x + v3.x, v1.y + v3.y);
  y2 = make_float2(v0.x - v2.x, v0.y - v2.y);
  y3 = make_float2(v1.x - v3.x, v1.y - v3.y);
}
DI void fft4096(float2* buf, const float2* __restrict__ tw, const float2* twl, int tid) {
#pragma unroll 1
  for (int lp = 0; lp < 12; lp += 4) {
    int p = 1 << lp;
    int sh = 8 - lp;
    int k = tid & (p - 1);
    int j = ((tid - k) << 4) + k;
    float2 u[16];
#pragma unroll
    for (int n = 0; n < 16; n++) u[n] = buf[bi(tid + 256 * n)];
    if (lp == 4) {
#pragma unroll
      for (int n = 1; n < 16; n++) { int m = (k * n) << sh; u[n] = cmul(u[n], twl[m >> 2]); }
    } else if (lp == 8) {
#pragma unroll
      for (int n = 1; n < 16; n++) { int m = k * n; u[n] = cmul(u[n], cmul(twl[m >> 2], twl[1024 + (m & 3)])); }
    }
    const float c1 = 0.92387953251128674f, s1 = 0.38268343236508977f, h = 0.70710678118654752f;
#pragma unroll
    for (int bq = 0; bq < 4; bq++) {
      float2 r0, r1, r2, r3;
      dft4(u[bq], u[4 + bq], u[8 + bq], u[12 + bq], r0, r1, r2, r3);
      if (bq == 1) { r1 = cmul(r1, make_float2(c1, -s1)); r2 = cmul(r2, make_float2(h, -h)); r3 = cmul(r3, make_float2(s1, -c1)); }
      if (bq == 2) { r1 = cmul(r1, make_float2(h, -h)); r2 = make_float2(r2.y, -r2.x); r3 = cmul(r3, make_float2(-h, -h)); }
      if (bq == 3) { r1 = cmul(r1, make_float2(s1, -c1)); r2 = cmul(r2, make_float2(-h, -h)); r3 = cmul(r3, make_float2(-c1, s1)); }
      u[bq] = r0; u[4 + bq] = r1; u[8 + bq] = r2; u[12 + bq] = r3;
    }
    __syncthreads();
#pragma unroll
    for (int c = 0; c < 4; c++) {
      float2 r0, r1, r2, r3;
      dft4(u[4 * c], u[4 * c + 1], u[4 * c + 2], u[4 * c + 3], r0, r1, r2, r3);
      buf[bi(j + (c) * p)] = r0; buf[bi(j + (c + 4) * p)] = r1; buf[bi(j + (c + 8) * p)] = r2; buf[bi(j + (c + 12) * p)] = r3;
    }
    __syncthreads();
  }
}

NI void phase0(PRef P, unsigned char* smem) {
  unsigned char* ws = P.ws;
  float* partial = (float*)(ws + OFF_PART);
  float* rmem = (float*)(ws + OFF_RMEM);
  float2* tw = (float2*)(ws + OFF_TW);
  float2* rope = (float2*)(ws + OFF_ROPE);
  float* h2 = (float*)(ws + OFF_H2);
  int tid = opaque_tid();
  int gtid = blockIdx.x * NT + tid, gsz = gridDim.x * NT;
  if (gtid == 0) *(int*)(P.ws + OFF_PROBE) = 1;
  for (int i = gtid; i < 4096; i += gsz) {
    float s, c; sincospif(2.0f * (float)i / 4096.0f, &s, &c);
    tw[i] = make_float2(c, -s);
  }
  for (int i = gtid; i < 1024; i += gsz) {
    int pos = i >> 4, f = i & 15;
    float inv = powf(10000.0f, -(float)f / 16.0f);
    float a = (float)pos * inv;
    rope[i] = make_float2(cosf(a), sinf(a));
  }
  int lane = tid & 63;
  int gw = gtid >> 6, nw = gsz >> 6;
  for (int row = gw; row < TOK + 2048; row += nw) {
    const float* src = row < TOK ? P.in[0] + (size_t)row * 1024 : P.in[1] + (size_t)(row - TOK) * 1024;
    float ss = 0.f;
#pragma unroll
    for (int i = 0; i < 4; i++) {
      float4 v = *(const float4*)(src + i * 256 + lane * 4);
      ss += v.x * v.x + v.y * v.y + v.z * v.z + v.w * v.w;
      if (row < TOK) *(uint2*)((bf16_t*)(P.ws + OFF_HB) + (size_t)row * 1024 + i * 256 + lane * 4) = make_uint2(pk2(v.x, v.y), pk2(v.z, v.w));
    }
#pragma unroll
    for (int o = 32; o > 0; o >>= 1) ss += __shfl_xor(ss, o);
    if (row < TOK) {
      if (lane < 16) partial[(size_t)row * 16 + lane] = lane == 0 ? ss : 0.f;
    } else if (lane == 0) rmem[row - TOK] = rsqrtf(ss * (1.f / 1024.f) + 1e-6f);
  }
  for (int it = gw; it < 2 * SEQ; it += nw) {
    int l = it >> 11, t = it & 2047;
    const float* w1 = P.in[7] + (size_t)l * 33 * 64;
    const float* b1 = P.in[8] + l * 64;
    const float* w2 = P.in[9] + (size_t)l * 64 * 64;
    const float* b2 = P.in[10] + l * 64;
    const float* fr = P.in[13] + l * 128;
    float zv = 0.f;
    if (lane == 0) zv = (float)t / 2047.0f;
    else if (lane < 33) {
      int kb = (lane - 1) & 15;
      float fk = 1e-4f + (float)kb * ((15.0f - 1e-4f) / 15.0f);
      float wv = 2.0f * 3.14159265358979323846f * (float)t / 2048.0f;
      float a = wv * fk;
      zv = lane <= 16 ? cosf(a) : -sinf(a);
    }
    float acc = b1[lane];
    for (int k = 0; k < 33; k++) acc += __shfl(zv, k) * w1[k * 64 + lane];
    float h1 = sinf(fr[lane] * acc);
    float acc2 = b2[lane];
    for (int k = 0; k < 64; k++) acc2 += __shfl(h1, k) * w2[k * 64 + lane];
    h2[(size_t)it * 64 + lane] = sinf(fr[64 + lane] * acc2);
  }
}

NI void hy_spectra_job(PRef P, int l, int c, unsigned char* smem) {
  float2* buf = (float2*)smem;
  float* w3s = (float*)(smem + 49664);
  float* red = (float*)(smem + 49664 + 1024);
  unsigned char* ws = P.ws;
  const float* h2 = (const float*)(ws + OFF_H2) + (size_t)l * SEQ * 64;
  const float2* tw = (const float2*)(ws + OFF_TW);
  float2* spec = (float2*)(ws + OFF_SPEC);
  const float* w3 = P.in[11] + (size_t)l * 64 * 2048;
  const float* b3 = P.in[12] + (size_t)l * 2048;
  int tid = opaque_tid();
  float2* twl = (float2*)(smem + 40960);
  __syncthreads();
  fft_fill_twl(twl, tw, tid);
  {
    int j = tid >> 6, k = tid & 63;
    w3s[j * 64 + k] = w3[(size_t)k * 2048 + j * 512 + c];
  }
  __syncthreads();
  float bb[4];
#pragma unroll
  for (int j = 0; j < 4; j++) bb[j] = b3[j * 512 + c];
  const float la = -4.605170185988091f / 0.3f, lb = -4.605170185988091f / 1.5f;
  float delta = fabsf(la + (lb - la) * ((float)c / 511.0f));
  float n0 = 0.f, n1 = 0.f;
#pragma unroll 1
  for (int i = 0; i < 8; i++) {
    int t = tid + 256 * i;
    float v[4] = {bb[0], bb[1], bb[2], bb[3]};
    const float4* hr = (const float4*)(h2 + (size_t)t * 64);
#pragma unroll 4
    for (int k4 = 0; k4 < 16; k4++) {
      float4 hv = hr[k4];
#pragma unroll
      for (int j = 0; j < 4; j++) {
        const float* wj = w3s + j * 64 + k4 * 4;
        v[j] += hv.x * wj[0] + hv.y * wj[1] + hv.z * wj[2] + hv.w * wj[3];
      }
    }
    float win = __expf(-((float)t / 2047.0f) * delta);
#pragma unroll
    for (int j = 0; j < 4; j++) v[j] *= win;
    buf[bi(t)] = make_float2(v[0], v[2]);
    n0 += fabsf(v[0]); n1 += fabsf(v[2]);
    if (t >= 1) { buf[bi(4096 - t)] = make_float2(v[1], v[3]); n0 += fabsf(v[1]); n1 += fabsf(v[3]); }
    else buf[bi(2048)] = make_float2(0.f, 0.f);
  }
#pragma unroll
  for (int o = 32; o > 0; o >>= 1) { n0 += __shfl_xor(n0, o); n1 += __shfl_xor(n1, o); }
  if ((tid & 63) == 0) { red[(tid >> 6)] = n0; red[4 + (tid >> 6)] = n1; }
  __syncthreads();
  float inv0 = 0.5f / (red[0] + red[1] + red[2] + red[3] + 1e-6f);
  float inv1 = 0.5f / (red[4] + red[5] + red[6] + red[7] + 1e-6f);
  fft4096(buf, tw, twl, tid);
#pragma unroll 2
  for (int i = 0; i < 16; i++) {
    int k = tid + 256 * i;
    float2 a = buf[bi(k)], b = buf[bi((4096 - k) & 4095)];
    if (k <= 2048) {
      spec[((size_t)c * 2 + 0) * 2049 + k] = make_float2((a.x + b.x) * inv0, (a.y - b.y) * inv0);
      spec[((size_t)c * 2 + 1) * 2049 + k] = make_float2((a.y + b.y) * inv1, -(a.x - b.x) * inv1);
    }
  }
  __syncthreads();
}

DI float hy_sc(const bf16_t* row, int t, float w0, float w1, float w2) {
  float a = t > 0 ? bf2f(row[t - 1]) : 0.f;
  float b = bf2f(row[t]);
  float d = t < SEQ - 1 ? bf2f(row[t + 1]) : 0.f;
  return w0 * a + w1 * b + w2 * d;
}
NI void hy_conv_job(PRef P, int l, int c, int pr, unsigned char* smem, bool dry) {
  float2* buf = (float2*)smem;
  unsigned char* ws = P.ws;
  const float2* tw = (const float2*)(ws + OFF_TW);
  const float2* H0 = (const float2*)(ws + OFF_SPEC) + ((size_t)c * 2) * 2049;
  const float2* H1 = H0 + 2049;
  bf16_t* hyT = (bf16_t*)(ws + OFF_HYT);
  const float* cw = P.in[6] + (size_t)l * 3 * 1536;
  const float* skip = P.in[14] + (size_t)l * 1024;
  int tid = opaque_tid();
  int b0 = 2 * pr, b1 = 2 * pr + 1;
  bf16_t* rv0 = hyT + ((size_t)b0 * 1536 + c) * SEQ;
  bf16_t* rv1 = hyT + ((size_t)b1 * 1536 + c) * SEQ;
  const bf16_t* rx10 = rv0 + (size_t)512 * SEQ; const bf16_t* rx11 = rv1 + (size_t)512 * SEQ;
  const bf16_t* rx20 = rv0 + (size_t)1024 * SEQ; const bf16_t* rx21 = rv1 + (size_t)1024 * SEQ;
  float wv0 = cw[c], wv1 = cw[1536 + c], wv2 = cw[3072 + c];
  float wa0 = cw[512 + c], wa1 = cw[1536 + 512 + c], wa2 = cw[3072 + 512 + c];
  float wb0 = cw[1024 + c], wb1 = cw[1536 + 1024 + c], wb2 = cw[3072 + 1024 + c];
  float sk0 = skip[c], sk1 = skip[512 + c];
  float va[8], vb[8];
  float2* twl = (float2*)(smem + 40960);
  __syncthreads();
  fft_fill_twl(twl, tw, tid);
#pragma unroll
  for (int i = 0; i < 8; i++) {
    int t = tid + 256 * i;
    va[i] = hy_sc(rv0, t, wv0, wv1, wv2);
    vb[i] = hy_sc(rv1, t, wv0, wv1, wv2);
    buf[bi(t)] = make_float2(va[i], vb[i]);
    buf[bi(t + 2048)] = make_float2(0.f, 0.f);
  }
  __syncthreads();
  fft4096(buf, tw, twl, tid);
  for (int i = 0; i < 16; i++) {
    int k = tid + 256 * i;
    float2 hk = k <= 2048 ? H0[k] : H0[4096 - k];
    if (k > 2048) hk.y = -hk.y;
    float2 w = cmul(buf[bi(k)], hk);
    buf[bi(k)] = make_float2(w.x, -w.y);
  }
  __syncthreads();
  fft4096(buf, tw, twl, tid);
  const float sc = 1.0f / 4096.0f;
#pragma unroll
  for (int i = 0; i < 8; i++) {
    int t = tid + 256 * i;
    float2 y = buf[bi(t)];
    float y0 = y.x * sc + va[i] * sk0;
    float y1 = -y.y * sc + vb[i] * sk0;
    float z0 = hy_sc(rx10, t, wa0, wa1, wa2) * y0;
    float z1 = hy_sc(rx11, t, wa0, wa1, wa2) * y1;
    va[i] = z0; vb[i] = z1;
    buf[bi(t)] = make_float2(z0, z1);
    buf[bi(t + 2048)] = make_float2(0.f, 0.f);
  }
  __syncthreads();
  fft4096(buf, tw, twl, tid);
  for (int i = 0; i < 16; i++) {
    int k = tid + 256 * i;
    float2 hk = k <= 2048 ? H1[k] : H1[4096 - k];
    if (k > 2048) hk.y = -hk.y;
    float2 w = cmul(buf[bi(k)], hk);
    buf[bi(k)] = make_float2(w.x, -w.y);
  }
  __syncthreads();
  fft4096(buf, tw, twl, tid);
#pragma unroll
  for (int i = 0; i < 8; i++) {
    int t = tid + 256 * i;
    float2 y = buf[bi(t)];
    float y0 = y.x * sc + va[i] * sk1;
    float y1 = -y.y * sc + vb[i] * sk1;
    float o0 = hy_sc(rx20, t, wb0, wb1, wb2) * y0;
    float o1 = hy_sc(rx21, t, wb0, wb1, wb2) * y1;
    va[i] = o0; vb[i] = o1;
  }
  __syncthreads();
#pragma unroll
  for (int i = 0; i < 8; i++) {
    int t = tid + 256 * i;
    if (!dry) { rv0[t] = (bf16_t)f2bf(va[i]); rv1[t] = (bf16_t)f2bf(vb[i]); }
  }
}


NI void wconv_job(PRef P, int it, unsigned char* smem) {
  int tid = opaque_tid();
  bf16_t* sW = (bf16_t*)smem;
  unsigned char* ws = P.ws;
  const float* src; const float* gain = nullptr; bf16_t* dst;
  int K = 1024, N = 1024, kt, nt, l;
  if (it < 1760) {
    l = it >= 880 ? 1 : 0; int r = it - l * 880;
    src = P.in[3] + (size_t)l * 1024 * NIN; gain = P.in[2] + l * 1024; dst = (bf16_t*)(ws + OFF_WB) + (size_t)l * WS_WIN; N = NIN; nt = r % 55; kt = r / 55;
  } else {
    int r = it - 1760; l = r >= NWL ? 1 : 0; r -= l * NWL;
    bf16_t* wo = (bf16_t*)P.out + (size_t)l * WO_LAYER;
    if (r < 128) { src = P.in[21] + (size_t)l * 1024 * 1024; dst = wo + WO_WOUT; nt = r & 7; kt = r >> 3; }
    else if (r < 256) { r -= 128; src = P.in[24] + (size_t)l * 1024 * 1024; gain = P.in[22] + l * 1024; dst = wo + WO_WQ; nt = r & 7; kt = r >> 3; }
    else if (r < 768) { r -= 256; src = P.in[31] + (size_t)l * 1024 * 4096; gain = P.in[30] + l * 1024; dst = wo + WO_W1; N = 4096; nt = r & 31; kt = r >> 5; }
    else if (r < 1280) { r -= 768; src = P.in[32] + (size_t)l * 4096 * 1024; dst = l == 0 ? wo + WO_W2 : (bf16_t*)(ws + OFF_WB) + WS_W2L1; K = 4096; nt = r & 7; kt = r >> 3; }
    else if (r < 1280 + 384) {
      r -= 1280; int which = r >> 7, rr = r & 127; nt = rr & 7; kt = rr >> 3;
      if (which == 0) { src = P.in[25]; dst = wo + WO_WK; gain = P.in[23] + l * 1024; }
      else if (which == 1) { src = P.in[26]; dst = wo + WO_WV; gain = P.in[23] + l * 1024; }
      else { src = P.in[27]; dst = wo + WO_WO; }
      src += (size_t)l * 1024 * 1024;
    } else {
      r -= 1280 + 384; int br = r >> 6, rr = r & 63; K = 512; nt = rr & 7; kt = rr >> 3;
      src = (br == 0 ? P.in[18] : br == 1 ? P.in[19] : P.in[20]) + (size_t)l * 512 * 1024; dst = wo + WO_BR + (size_t)br * 524288;
    }
  }
  int n0 = nt * 128, k0 = kt * 64;
  int valid = N - n0 < 128 ? N - n0 : 128;
  LdKMajF32<128> lw; lw.tid = tid; lw.p = src + n0; lw.ld = N; lw.gain = gain; lw.ncol = valid;
  lw.load(k0);
  __syncthreads();
  lw.store(sW);
  __syncthreads();
  int n = tid >> 1, half = tid & 1;
  if (n < valid) {
#pragma unroll
    for (int e = 0; e < 4; e++)
      *(uint4*)(dst + (size_t)(n0 + n) * K + k0 + half * 32 + e * 8) = *(const uint4*)(sW + swz_off(n, half * 32 + e * 8));
  }
}

NI void inproj_tile(PRef P, int l, const float* hsrc, int mt, int nt, unsigned char* smem) {
  int tid = opaque_tid();
  bf16_t* sW = (bf16_t*)smem; bf16_t* sA = (bf16_t*)(smem + 18432);
  unsigned char* ws = P.ws;
  const float* partial = (const float*)(ws + OFF_PART);
  int m0 = mt * 128, n0 = nt * 128;
  LdRowBf16<128> la; la.tid = tid; la.p = (const bf16_t*)(ws + OFF_HB) + (size_t)m0 * 1024; la.ld = 1024;
  LdRowBf16<128> lw; lw.tid = tid; lw.p = (const bf16_t*)(ws + OFF_WB) + (size_t)l * WS_WIN + (size_t)n0 * 1024; lw.ld = 1024;
  f32x4 acc[4][4]; zero_acc<4>(acc);
  gemm_kloop<4>(la, lw, 1024, acc, sW, sA);
  int lane = tid & 63, w = tid >> 6, r = lane & 15, q = lane >> 4, wn = w >> 1, wm = w & 1;
#pragma unroll
  for (int mi = 0; mi < 4; mi++) {
    int m = m0 + wm * 64 + mi * 16 + r;
    float rs = row_rstd(partial, m);
#pragma unroll
    for (int ni = 0; ni < 4; ni++) acc[ni][mi] *= rs;
  }
  if (nt <= 4) {
    const float* gn = (nt < 4 ? P.in[4] : P.in[5]) + l * 64;
    const float2* rope = (const float2*)(ws + OFF_ROPE);
    bf16_t* dst = nt < 4 ? (bf16_t*)(ws + OFF_Q) : (bf16_t*)(ws + OFF_K);
    int ldd = nt < 4 ? 512 : 128;
    int cbase = (nt < 4 ? nt * 128 : 0) + wn * 64;
    f32x4 g[4];
#pragma unroll
    for (int ni = 0; ni < 4; ni++) g[ni] = *(const f32x4*)(gn + ni * 16 + q * 4);
#pragma unroll
    for (int mi = 0; mi < 4; mi++) {
      int m = m0 + wm * 64 + mi * 16 + r;
      float ss = 0.f;
#pragma unroll
      for (int ni = 0; ni < 4; ni++)
#pragma unroll
        for (int j = 0; j < 4; j++) ss += acc[ni][mi][j] * acc[ni][mi][j];
      ss += __shfl_xor(ss, 16); ss += __shfl_xor(ss, 32);
      float rs = rsqrtf(ss * (1.f / 64.f) + 1e-6f);
      int t = m & 2047;
      int prow = t >> 6, pcol = t & 63;
      f32x4 y[4];
#pragma unroll
      for (int ni = 0; ni < 4; ni++) y[ni] = acc[ni][mi] * rs * g[ni];
      f32x4 o[4];
#pragma unroll
      for (int j = 0; j < 4; j++) {
        float2 cr = rope[prow * 16 + q * 4 + j];
        float2 cc = rope[pcol * 16 + q * 4 + j];
        o[0][j] = y[0][j] * cr.x - y[1][j] * cr.y;
        o[1][j] = y[0][j] * cr.y + y[1][j] * cr.x;
        o[2][j] = y[2][j] * cc.x - y[3][j] * cc.y;
        o[3][j] = y[2][j] * cc.y + y[3][j] * cc.x;
      }
#pragma unroll
      for (int ni = 0; ni < 4; ni++)
        *(uint2*)(dst + (size_t)m * ldd + cbase + ni * 16 + q * 4) = make_uint2(pk2(o[ni][0], o[ni][1]), pk2(o[ni][2], o[ni][3]));
    }
  } else if (nt <= 17) {
    bf16_t* dst; int chbase, nch;
    if (nt == 5) { dst = (bf16_t*)(ws + OFF_VT); chbase = 0; nch = 128; }
    else { dst = (bf16_t*)(ws + OFF_HYT); chbase = (nt - 6) * 128; nch = 1536; }
    bf16_t* sT = (bf16_t*)smem;
    __syncthreads();
#pragma unroll
    for (int mi = 0; mi < 4; mi++) {
      int tl = wm * 64 + mi * 16 + r;
#pragma unroll
      for (int ni = 0; ni < 4; ni++)
#pragma unroll
        for (int j = 0; j < 4; j++) sT[(wn * 64 + ni * 16 + q * 4 + j) * 136 + tl] = (bf16_t)f2bf(acc[ni][mi][j]);
    }
    __syncthreads();
    {
      int b = m0 >> 11, t0 = m0 & 2047;
#pragma unroll
      for (int i = 0; i < 8; i++) {
        int id = tid + 256 * i;
        int ch = id >> 4, c16 = id & 15;
        uint4 v = *(const uint4*)(sT + ch * 136 + c16 * 8);
        *(uint4*)(dst + ((size_t)b * nch + chbase + ch) * SEQ + t0 + c16 * 8) = v;
      }
    }
  } else if (nt <= 29) {
    bf16_t* dst; int ldd, cbase;
    if (nt <= 19) { dst = (bf16_t*)(ws + OFF_GQ); ldd = 256; cbase = (nt - 18) * 128; }
    else if (nt <= 21) { dst = (bf16_t*)(ws + OFF_GK); ldd = 256; cbase = (nt - 20) * 128; }
    else if (nt <= 25) { dst = (bf16_t*)(ws + OFF_GV); ldd = 512; cbase = (nt - 22) * 128; }
    else { dst = (bf16_t*)(ws + OFF_GO); ldd = 512; cbase = (nt - 26) * 128; }
    cbase += wn * 64;
#pragma unroll
    for (int mi = 0; mi < 4; mi++) {
      int m = m0 + wm * 64 + mi * 16 + r;
#pragma unroll
      for (int ni = 0; ni < 4; ni++)
        *(uint2*)(dst + (size_t)m * ldd + cbase + ni * 16 + q * 4) =
            make_uint2(pk2(acc[ni][mi][0], acc[ni][mi][1]), pk2(acc[ni][mi][2], acc[ni][mi][3]));
    }
  } else {
    float* dst = (float*)(ws + OFF_GLR);
    if (wn == 0) {
#pragma unroll
      for (int mi = 0; mi < 4; mi++) {
        int m = m0 + wm * 64 + mi * 16 + r;
#pragma unroll
        for (int ni = 0; ni < 2; ni++) *(f32x4*)(dst + (size_t)m * 32 + ni * 16 + q * 4) = acc[ni][mi];
      }
    }
  }
}

NI void attn_unit(PRef P, int u, unsigned char* smem) {
  bf16_t* sK = (bf16_t*)smem;
  bf16_t* sVT = (bf16_t*)(smem + 9216);
  unsigned char* ws = P.ws;
  bf16_t* qb = (bf16_t*)(ws + OFF_Q);
  const bf16_t* kb = (const bf16_t*)(ws + OFF_K);
  const bf16_t* vt = (const bf16_t*)(ws + OFF_VT);
  int b = u >> 7, head = (u >> 4) & 7, qt = u & 15, kvh = head >> 2;
  int tid = opaque_tid(), lane = tid & 63, w = tid >> 6, ql = lane & 31, hh = lane >> 5;
  int tok = b * SEQ + qt * 128 + w * 32 + ql;
  bf16x8 qf[4];
#pragma unroll
  for (int ks = 0; ks < 4; ks++) qf[ks] = *(const bf16x8*)(qb + (size_t)tok * 512 + head * 64 + ks * 16 + hh * 8);
  f32x16 o[2];
#pragma unroll
  for (int i = 0; i < 16; i++) { o[0][i] = 0.f; o[1][i] = 0.f; }
  float mrun = -1e30f, lrun = 0.f;
  const float cs = 0.125f * 1.44269504088896f;
  uint4 pk[2], pv[2];
  int lrow = tid >> 3, lch = tid & 7;
  const bf16_t* kbase = kb + (size_t)(b * SEQ) * 128 + kvh * 64;
  const bf16_t* vbase = vt + (size_t)((b * 2 + kvh) * 64) * SEQ;
#pragma unroll
  for (int i = 0; i < 2; i++) {
    pk[i] = *(const uint4*)(kbase + (size_t)(lrow + 32 * i) * 128 + lch * 8);
    pv[i] = *(const uint4*)(vbase + (size_t)(lrow + 32 * i) * SEQ + lch * 8);
  }
  for (int kt = 0; kt < 32; kt++) {
    __syncthreads();
#pragma unroll
    for (int i = 0; i < 2; i++) {
      *(uint4*)(sK + (lrow + 32 * i) * 72 + lch * 8) = pk[i];
      *(uint2*)(sVT + (lrow + 32 * i) * 68 + lch * 8) = make_uint2(pv[i].x, pv[i].y);
      *(uint2*)(sVT + (lrow + 32 * i) * 68 + lch * 8 + 4) = make_uint2(pv[i].z, pv[i].w);
    }
    __syncthreads();
    if (kt + 1 < 32) {
#pragma unroll
      for (int i = 0; i < 2; i++) {
        pk[i] = *(const uint4*)(kbase + (size_t)((kt + 1) * 64 + lrow + 32 * i) * 128 + lch * 8);
        pv[i] = *(const uint4*)(vbase + (size_t)(lrow + 32 * i) * SEQ + (kt + 1) * 64 + lch * 8);
      }
    }
    f32x16 s[2];
#pragma unroll
    for (int i = 0; i < 16; i++) { s[0][i] = 0.f; s[1][i] = 0.f; }
#pragma unroll
    for (int mt2 = 0; mt2 < 2; mt2++)
#pragma unroll
      for (int ks = 0; ks < 4; ks++) {
        bf16x8 a = *(const bf16x8*)(sK + (mt2 * 32 + ql) * 72 + ks * 16 + hh * 8);
        s[mt2] = __builtin_amdgcn_mfma_f32_32x32x16_bf16(a, qf[ks], s[mt2], 0, 0, 0);
      }
    float mloc = s[0][0];
#pragma unroll
    for (int i = 0; i < 16; i++) { mloc = fmaxf(mloc, s[0][i]); mloc = fmaxf(mloc, s[1][i]); }
    mloc = fmaxf(mloc, __shfl_xor(mloc, 32));
    float mnew = fmaxf(mrun, mloc);
    bool grow = mnew > mrun;
    float alpha = __builtin_amdgcn_exp2f((mrun - mnew) * cs);
    mrun = mnew;
    float ls = 0.f;
    float mb = mnew * cs;
#pragma unroll
    for (int i = 0; i < 16; i++) {
      s[0][i] = __builtin_amdgcn_exp2f(s[0][i] * cs - mb); s[1][i] = __builtin_amdgcn_exp2f(s[1][i] * cs - mb);
      ls += s[0][i] + s[1][i];
    }
    lrun = lrun * alpha + ls;
    if (__any(grow)) {
#pragma unroll
      for (int i = 0; i < 16; i++) { o[0][i] *= alpha; o[1][i] *= alpha; }
    }
#pragma unroll
    for (int mt2 = 0; mt2 < 2; mt2++)
#pragma unroll
      for (int s2 = 0; s2 < 2; s2++) {
        union { bf16x8 v; unsigned u[4]; } pb;
#pragma unroll
        for (int j = 0; j < 4; j++) pb.u[j] = pk2(s[mt2][8 * s2 + 2 * j], s[mt2][8 * s2 + 2 * j + 1]);
#pragma unroll
        for (int dt = 0; dt < 2; dt++) {
          const bf16_t* vp = sVT + (dt * 32 + ql) * 68 + mt2 * 32 + s2 * 16 + hh * 4;
          union { bf16x8 v; uint2 u[2]; } av;
          av.u[0] = *(const uint2*)vp; av.u[1] = *(const uint2*)(vp + 8);
          o[dt] = __builtin_amdgcn_mfma_f32_32x32x16_bf16(av.v, pb.v, o[dt], 0, 0, 0);
        }
      }
  }
  float lt = lrun + __shfl_xor(lrun, 32);
  float inv = 1.f / lt;
#pragma unroll
  for (int dt = 0; dt < 2; dt++)
#pragma unroll
    for (int g = 0; g < 4; g++) {
      int d = dt * 32 + 8 * g + 4 * hh;
      *(uint2*)((bf16_t*)(ws + OFF_OA) + (size_t)tok * 512 + head * 64 + d) =
          make_uint2(pk2(o[dt][4 * g] * inv, o[dt][4 * g + 1] * inv), pk2(o[dt][4 * g + 2] * inv, o[dt][4 * g + 3] * inv));
    }
}

NI void memkv_tile(PRef P, int l, int mt, int nt, unsigned char* smem) {
  int tid = opaque_tid();
  bf16_t* sW = (bf16_t*)smem; bf16_t* sA = (bf16_t*)(smem + 18432);
  unsigned char* ws = P.ws;
  const float* rmem = (const float*)(ws + OFF_RMEM);
  int m0 = mt * 128;
  LdRowF32<128> la; la.tid = tid; la.p = P.in[1] + (size_t)m0 * 1024; la.ld = 1024; la.gain = nullptr;
  LdRowBf16<128> lw; lw.tid = tid; lw.p = (const bf16_t*)P.out + (size_t)l * WO_LAYER + (nt < 8 ? WO_WK : WO_WV) + (size_t)(nt & 7) * 128 * 1024; lw.ld = 1024;
  f32x4 acc[4][4]; zero_acc<4>(acc);
  gemm_kloop<4>(la, lw, 1024, acc, sW, sA);
  int lane = tid & 63, w = tid >> 6, r = lane & 15, q = lane >> 4, wn = w >> 1, wm = w & 1;
  bf16_t* mk = (bf16_t*)(ws + OFF_MEMK);
  bf16_t* mvt = (bf16_t*)(ws + OFF_MEMVT);
#pragma unroll
  for (int mi = 0; mi < 4; mi++) {
    int m = m0 + wm * 64 + mi * 16 + r;
    float rs = rmem[m];
#pragma unroll
    for (int ni = 0; ni < 4; ni++) {
      f32x4 v = acc[ni][mi] * rs;
      int n = (nt & 7) * 128 + wn * 64 + ni * 16 + q * 4;
      if (nt < 8) {
        *(uint2*)(mk + (size_t)m * 1024 + n) = make_uint2(pk2(v[0], v[1]), pk2(v[2], v[3]));
      } else {
        int b = m >> 8, key = m & 255;
#pragma unroll
        for (int j = 0; j < 4; j++) {
          int nn = n + j; int h = nn >> 8, d = nn & 255;
          mvt[(((size_t)b * 4 + h) * 256 + d) * 256 + key] = (bf16_t)f2bf(v[j]);
        }
      }
    }
  }
}

DI float logsigf(float x) { return fminf(x, 0.f) - log1pf(__expf(-fabsf(x))); }
DI void gla_gates(PRef P, int l, int h, int t0, int tid, const float* glrS, float* psum, float (&g)[32], float& off, float& total) {
  int d = tid & 63, dir = (tid >> 6) & 1, half = tid >> 7;
  const float* wl = P.in[15] + ((size_t)(l * 2 + dir) * 16) * 256 + h * 64 + d;
  float wr[16];
#pragma unroll
  for (int r = 0; r < 16; r++) wr[r] = wl[r * 256];
  float bias = P.in[16][(size_t)(l * 2 + dir) * 256 + h * 64 + d];
  float ps = 0.f;
#pragma unroll
  for (int j = 0; j < 32; j++) {
    int i = 32 * half + j;
    int c = dir ? 63 - i : i;
    const float* lr = glrS + c * 32 + dir * 16;
    float lg = bias;
#pragma unroll
    for (int r = 0; r < 16; r++) lg += lr[r] * wr[r];
    g[j] = logsigf(lg) * (1.f / 16.f);
    ps += g[j];
  }
  psum[(dir * 2 + half) * 64 + d] = ps;
  __syncthreads();
  float p0 = psum[(dir * 2) * 64 + d], p1 = psum[(dir * 2 + 1) * 64 + d];
  off = half ? p0 : 0.f;
  total = p0 + p1;
}
NI void gla_state_unit(PRef P, int l, int u, unsigned char* smem) {
  bf16_t* sVT = (bf16_t*)smem;
  bf16_t* sKK = (bf16_t*)(smem + 18432);
  float* glrS = (float*)(smem + 36864);
  float* psum = (float*)(smem + 45056);
  unsigned char* ws = P.ws;
  const bf16_t* gk = (const bf16_t*)(ws + OFF_GK);
  const bf16_t* gv = (const bf16_t*)(ws + OFF_GV);
  const float* glr = (const float*)(ws + OFF_GLR);
  float* decay = (float*)(ws + OFF_DECAY);
  bf16_t* gst = (bf16_t*)(ws + OFF_GST);
  int bh = u >> 5, m = u & 31, b = bh >> 2, h = bh & 3;
  int t0 = b * SEQ + m * 64;
  int tid = opaque_tid();
  __syncthreads();
#pragma unroll
  for (int i = 0; i < 8; i++) { int idx = tid + 256 * i; glrS[idx] = glr[(size_t)t0 * 32 + idx]; }
  {
    LdKMajBf16<128, false> lv; lv.tid = tid; lv.p = gv + (size_t)t0 * 512 + h * 128; lv.ld = 512;
    lv.load(0); lv.store(sVT);
  }
  __syncthreads();
  {
    float g[32], off, total;
    gla_gates(P, l, h, t0, tid, glrS, psum, g, off, total);
    int d = tid & 63, dir = (tid >> 6) & 1, half = tid >> 7;
    if (half == 0) decay[((size_t)u * 2 + dir) * 64 + d] = __expf(total);
    float val[32];
    float run = off;
#pragma unroll
    for (int j = 0; j < 32; j++) {
      int i = 32 * half + j;
      int c = dir ? 63 - i : i;
      run += g[j];
      float kv = bf2f(gk[(size_t)(t0 + c) * 256 + h * 64 + d]);
      val[j] = kv * __expf(total - run);
    }
    int cbase = dir ? 32 * (1 - half) : 32 * half;
#pragma unroll
    for (int mq = 0; mq < 4; mq++) {
      unsigned pw[4];
#pragma unroll
      for (int e = 0; e < 4; e++) {
        int jj = mq * 8 + e * 2;
        float a0 = dir ? val[31 - jj] : val[jj];
        float a1 = dir ? val[30 - jj] : val[jj + 1];
        pw[e] = pk2(a0, a1);
      }
      *(uint4*)(sKK + (dir * 64 + d) * 72 + cbase + mq * 8) = make_uint4(pw[0], pw[1], pw[2], pw[3]);
    }
  }
  __syncthreads();
  int lane = tid & 63, w = tid >> 6, r = lane & 15, q = lane >> 4;
  f32x4 acc[2][4][2];
#pragma unroll
  for (int a = 0; a < 2; a++)
#pragma unroll
    for (int bq = 0; bq < 4; bq++)
#pragma unroll
      for (int cq = 0; cq < 2; cq++) acc[a][bq][cq] = (f32x4){0.f, 0.f, 0.f, 0.f};
#pragma unroll
  for (int kk = 0; kk < 2; kk++) {
    bf16x8 bv[2];
#pragma unroll
    for (int et = 0; et < 2; et++) bv[et] = *(const bf16x8*)(sVT + (32 * w + et * 16 + r) * 72 + kk * 32 + q * 8);
#pragma unroll
    for (int dir = 0; dir < 2; dir++)
#pragma unroll
      for (int dt = 0; dt < 4; dt++) {
        bf16x8 a = *(const bf16x8*)(sKK + (dir * 64 + dt * 16 + r) * 72 + kk * 32 + q * 8);
#pragma unroll
        for (int et = 0; et < 2; et++) acc[dir][dt][et] = __builtin_amdgcn_mfma_f32_16x16x32_bf16(a, bv[et], acc[dir][dt][et], 0, 0, 0);
      }
  }
#pragma unroll
  for (int dir = 0; dir < 2; dir++)
#pragma unroll
    for (int dt = 0; dt < 4; dt++)
#pragma unroll
      for (int et = 0; et < 2; et++) {
        int e = 32 * w + et * 16 + r, d = dt * 16 + q * 4;
        f32x4 v = acc[dir][dt][et];
        *(uint2*)(gst + (((size_t)u * 2 + dir) * 128 + e) * 64 + d) = make_uint2(pk2(v[0], v[1]), pk2(v[2], v[3]));
      }
}

NI void gla_scan_unit(PRef P, int su, bool dry) {
  unsigned char* ws = P.ws;
  const float* decay = (const float*)(ws + OFF_DECAY);
  bf16_t* gst = (bf16_t*)(ws + OFF_GST);
  int id = su * 256 + opaque_tid();
  int d4 = id & 15, e = (id >> 4) & 127, dir = (id >> 11) & 1, bh = id >> 12;
  float S0 = 0.f, S1 = 0.f, S2 = 0.f, S3 = 0.f;
#pragma unroll 1
  for (int s0 = 0; s0 < 32; s0 += 8) {
    uint2 ds[8]; float4 dc[8];
#pragma unroll
    for (int i = 0; i < 8; i++) {
      int m = dir ? 31 - (s0 + i) : s0 + i;
      int u = bh * 32 + m;
      ds[i] = *(const uint2*)(gst + (((size_t)u * 2 + dir) * 128 + e) * 64 + d4 * 4);
      dc[i] = *(const float4*)(decay + ((size_t)u * 2 + dir) * 64 + d4 * 4);
    }
#pragma unroll
    for (int i = 0; i < 8; i++) {
      int m = dir ? 31 - (s0 + i) : s0 + i;
      int u = bh * 32 + m;
      bf16_t* ptr = gst + (((size_t)u * 2 + dir) * 128 + e) * 64 + d4 * 4;
      if (!dry) *(uint2*)ptr = make_uint2(pk2(S0, S1), pk2(S2, S3));
      S0 = dc[i].x * S0 + bflo(ds[i].x); S1 = dc[i].y * S1 + bfhi(ds[i].x);
      S2 = dc[i].z * S2 + bflo(ds[i].y); S3 = dc[i].w * S3 + bfhi(ds[i].y);
    }
  }
}

NI void gla_out_unit(PRef P, int l, int u, unsigned char* smem, bool dry) {
  bf16_t* sQ = (bf16_t*)smem;
  bf16_t* sK = (bf16_t*)(smem + 18432);
  bf16_t* sVT = (bf16_t*)(smem + 36864);
  float* glrS = (float*)(smem + 36864);
  float* psum = (float*)(smem + 36864 + 8192);
  float* red = (float*)(smem + 55296);
  unsigned char* ws = P.ws;
  const bf16_t* gq = (const bf16_t*)(ws + OFF_GQ);
  const bf16_t* gk = (const bf16_t*)(ws + OFF_GK);
  const bf16_t* gv = (const bf16_t*)(ws + OFF_GV);
  bf16_t* go = (bf16_t*)(ws + OFF_GO);
  const float* glr = (const float*)(ws + OFF_GLR);
  const bf16_t* gst = (const bf16_t*)(ws + OFF_GST);
  int bh = u >> 5, m = u & 31, b = bh >> 2, h = bh & 3;
  int t0 = b * SEQ + m * 64;
  int tid = opaque_tid();
  __syncthreads();
#pragma unroll
  for (int i = 0; i < 8; i++) { int idx = tid + 256 * i; glrS[idx] = glr[(size_t)t0 * 32 + idx]; }
  __syncthreads();
  {
    float g[32], off, total;
    gla_gates(P, l, h, t0, tid, glrS, psum, g, off, total);
    int d = tid & 63, dir = (tid >> 6) & 1, half = tid >> 7;
    float run = off;
#pragma unroll
    for (int j = 0; j < 32; j++) {
      int i = 32 * half + j;
      int c = dir ? 63 - i : i;
      run += g[j];
      float qv = bf2f(gq[(size_t)(t0 + c) * 256 + h * 64 + d]) * 0.125f;
      float kv = bf2f(gk[(size_t)(t0 + c) * 256 + h * 64 + d]);
      sQ[(dir * 64 + c) * 72 + d] = (bf16_t)f2bf(qv * __expf(run));
      sK[(dir * 64 + c) * 72 + d] = (bf16_t)f2bf(kv * __expf(-run));
    }
  }
  __syncthreads();
  {
    LdKMajBf16<128, false> lv; lv.tid = tid; lv.p = gv + (size_t)t0 * 512 + h * 128; lv.ld = 512;
    lv.load(0); lv.store(sVT);
  }
  __syncthreads();
  int lane = tid & 63, w = tid >> 6, r = lane & 15, q = lane >> 4;
  f32x4 o[2][4];
#pragma unroll
  for (int a = 0; a < 2; a++)
#pragma unroll
    for (int c = 0; c < 4; c++) o[a][c] = (f32x4){0.f, 0.f, 0.f, 0.f};
#pragma unroll
  for (int dir = 0; dir < 2; dir++) {
    f32x4 at[4][4];
#pragma unroll
    for (int a = 0; a < 4; a++)
#pragma unroll
      for (int c = 0; c < 4; c++) at[a][c] = (f32x4){0.f, 0.f, 0.f, 0.f};
#pragma unroll
    for (int kk = 0; kk < 2; kk++) {
      bf16x8 ka[4], qb[4];
#pragma unroll
      for (int st = 0; st < 4; st++) ka[st] = *(const bf16x8*)(sK + (dir * 64 + st * 16 + r) * 72 + kk * 32 + q * 8);
#pragma unroll
      for (int ct = 0; ct < 4; ct++) qb[ct] = *(const bf16x8*)(sQ + (dir * 64 + ct * 16 + r) * 72 + kk * 32 + q * 8);
#pragma unroll
      for (int st = 0; st < 4; st++)
#pragma unroll
        for (int ct = 0; ct < 4; ct++) at[st][ct] = __builtin_amdgcn_mfma_f32_16x16x32_bf16(ka[st], qb[ct], at[st][ct], 0, 0, 0);
    }
#pragma unroll
    for (int i = 0; i < 2; i++) {
      bf16x8 av[2];
#pragma unroll
      for (int et = 0; et < 2; et++) {
        const bf16_t* vp = sVT + (32 * w + et * 16 + r) * 72 + 32 * i + 4 * q;
        union { bf16x8 v; uint2 u2[2]; } t; t.u2[0] = *(const uint2*)vp; t.u2[1] = *(const uint2*)(vp + 16);
        av[et] = t.v;
      }
#pragma unroll
      for (int ct = 0; ct < 4; ct++) {
        int c = 16 * ct + r;
        float pv[8];
#pragma unroll
        for (int hf = 0; hf < 2; hf++)
#pragma unroll
          for (int j = 0; j < 4; j++) {
            int s = 16 * (2 * i + hf) + 4 * q + j;
            bool keep = dir == 0 ? (s <= c) : (s > c);
            pv[hf * 4 + j] = keep ? at[2 * i + hf][ct][j] : 0.f;
          }
        union { bf16x8 v; unsigned u4[4]; } pb;
#pragma unroll
        for (int j = 0; j < 4; j++) pb.u4[j] = pk2(pv[2 * j], pv[2 * j + 1]);
#pragma unroll
        for (int et = 0; et < 2; et++) o[et][ct] = __builtin_amdgcn_mfma_f32_16x16x32_bf16(av[et], pb.v, o[et][ct], 0, 0, 0);
      }
    }
#pragma unroll
    for (int kk = 0; kk < 2; kk++) {
      bf16x8 sa[2];
#pragma unroll
      for (int et = 0; et < 2; et++)
        sa[et] = *(const bf16x8*)(gst + (((size_t)u * 2 + dir) * 128 + 32 * w + et * 16 + r) * 64 + kk * 32 + q * 8);
#pragma unroll
      for (int ct = 0; ct < 4; ct++) {
        bf16x8 qb = *(const bf16x8*)(sQ + (dir * 64 + ct * 16 + r) * 72 + kk * 32 + q * 8);
#pragma unroll
        for (int et = 0; et < 2; et++) o[et][ct] = __builtin_amdgcn_mfma_f32_16x16x32_bf16(sa[et], qb, o[et][ct], 0, 0, 0);
      }
    }
  }
#pragma unroll
  for (int ct = 0; ct < 4; ct++) {
    float ss = 0.f;
#pragma unroll
    for (int et = 0; et < 2; et++)
#pragma unroll
      for (int j = 0; j < 4; j++) ss += o[et][ct][j] * o[et][ct][j];
    ss += __shfl_xor(ss, 16); ss += __shfl_xor(ss, 32);
    if (q == 0) red[w * 64 + ct * 16 + r] = ss;
  }
  __syncthreads();
  const float* onorm = P.in[17] + l * 128;
#pragma unroll
  for (int ct = 0; ct < 4; ct++) {
    int c = ct * 16 + r;
    float tot = red[c] + red[64 + c] + red[128 + c] + red[192 + c];
    float rs = rsqrtf(tot * (1.f / 128.f) + 1e-6f);
#pragma unroll
    for (int et = 0; et < 2; et++) {
      int e = 32 * w + et * 16 + 4 * q;
      f32x4 gn = *(const f32x4*)(onorm + e);
      bf16_t* gp = go + (size_t)(t0 + c) * 512 + h * 128 + e;
      uint2 gr = *(const uint2*)gp;
      float g0 = bflo(gr.x), g1 = bfhi(gr.x), g2 = bflo(gr.y), g3 = bfhi(gr.y);
      float y0 = o[et][ct][0] * rs * gn[0] * g0 * sigmoidf_(g0);
      float y1 = o[et][ct][1] * rs * gn[1] * g1 * sigmoidf_(g1);
      float y2 = o[et][ct][2] * rs * gn[2] * g2 * sigmoidf_(g2);
      float y3 = o[et][ct][3] * rs * gn[3] * g3 * sigmoidf_(g3);
      if (!dry) *(uint2*)gp = make_uint2(pk2(y0, y1), pk2(y2, y3));
    }
  }
}

NI void merge_tile(PRef P, int l, const float* hsrc, int mt, int nt, unsigned char* smem) {
  int tid = opaque_tid();
  bf16_t* sW = (bf16_t*)smem; bf16_t* sA = (bf16_t*)(smem + 18432);
  uint4* gslot = (uint4*)(smem + 36864) + tid * 4;
  unsigned char* ws = P.ws;
  const float* partial = (const float*)(ws + OFF_PART);
  int m0 = mt * 128, n0 = nt * 128;
  int lane = tid & 63, w = tid >> 6, r = lane & 15, q = lane >> 4, wn = w >> 1, wm = w & 1;
  f32x4 mix[4][4]; zero_acc<4>(mix);
#pragma unroll 1
  for (int br = 0; br < 3; br++) {
    f32x4 acc[4][4]; zero_acc<4>(acc);
    {
      int tid = opaque_tid();
      LdRowBf16<128> la; la.tid = tid; la.p = (const bf16_t*)(ws + OFF_HB) + (size_t)m0 * 1024; la.ld = 1024;
      LdRowBf16<128> lw; lw.tid = tid; lw.p = (const bf16_t*)(ws + OFF_WB) + (size_t)l * WS_WIN + (size_t)(3872 + br * 1024 + n0) * 1024; lw.ld = 1024;
      gemm_kloop<4>(la, lw, 1024, acc, sW, sA);
    }
#pragma unroll
    for (int mi = 0; mi < 4; mi++) {
      float rs = row_rstd(partial, m0 + wm * 64 + mi * 16 + r);
      unsigned pw[4];
#pragma unroll
      for (int ni = 0; ni < 4; ni++) {
        f32x4 v = acc[ni][mi] * rs;
        unsigned b0 = (unsigned)(sigmoidf_(v[0]) * 255.f + 0.5f), b1 = (unsigned)(sigmoidf_(v[1]) * 255.f + 0.5f);
        unsigned b2 = (unsigned)(sigmoidf_(v[2]) * 255.f + 0.5f), b3 = (unsigned)(sigmoidf_(v[3]) * 255.f + 0.5f);
        pw[ni] = b0 | (b1 << 8) | (b2 << 16) | (b3 << 24);
      }
      gslot[mi] = make_uint4(pw[0], pw[1], pw[2], pw[3]);
    }
    zero_acc<4>(acc);
    {
      int tid = opaque_tid();
      LdRowBf16<128> lw; lw.tid = tid; lw.p = (const bf16_t*)P.out + (size_t)l * WO_LAYER + WO_BR + (size_t)br * 524288 + (size_t)n0 * 512; lw.ld = 512;
      if (br == 1) {
        int b = m0 >> 11, t = m0 & 2047;
        LdKMajBf16<128> la; la.tid = tid; la.p = (const bf16_t*)(ws + OFF_HYT) + (size_t)b * 1536 * SEQ + t; la.ld = SEQ;
        gemm_kloop<4>(la, lw, 512, acc, sW, sA);
      } else {
        LdRowBf16<128> la; la.tid = tid; la.p = (const bf16_t*)(ws + (br == 0 ? OFF_OA : OFF_GO)) + (size_t)m0 * 512; la.ld = 512;
        gemm_kloop<4>(la, lw, 512, acc, sW, sA);
      }
    }
#pragma unroll
    for (int mi = 0; mi < 4; mi++) {
      uint4 gw = gslot[mi];
      unsigned pw[4] = {gw.x, gw.y, gw.z, gw.w};
#pragma unroll
      for (int ni = 0; ni < 4; ni++) {
        const float sc = 1.f / 255.f;
        mix[ni][mi][0] += (float)(pw[ni] & 255u) * sc * acc[ni][mi][0];
        mix[ni][mi][1] += (float)((pw[ni] >> 8) & 255u) * sc * acc[ni][mi][1];
        mix[ni][mi][2] += (float)((pw[ni] >> 16) & 255u) * sc * acc[ni][mi][2];
        mix[ni][mi][3] += (float)(pw[ni] >> 24) * sc * acc[ni][mi][3];
      }
    }
  }
  bf16_t* dst = (bf16_t*)(ws + OFF_MIXED);
#pragma unroll
  for (int mi = 0; mi < 4; mi++) {
    int m = m0 + wm * 64 + mi * 16 + r;
#pragma unroll
    for (int ni = 0; ni < 4; ni++)
      *(uint2*)(dst + (size_t)m * 1024 + n0 + wn * 64 + ni * 16 + q * 4) =
          make_uint2(pk2(mix[ni][mi][0], mix[ni][mi][1]), pk2(mix[ni][mi][2], mix[ni][mi][3]));
  }
}

template <bool WBF> NI void resid_tile(PRef P, const bf16_t* A, int lda, int K, const float* W, const bf16_t* Wt, bool final_out, int mt, int nt, unsigned char* smem, bool dry) {
  int tid = opaque_tid();
  bf16_t* sW = (bf16_t*)smem; bf16_t* sA = (bf16_t*)(smem + 18432);
  unsigned char* ws = P.ws;
  float* partial = (float*)(ws + OFF_PART);
  bf16_t* hb = (bf16_t*)(ws + OFF_HB);
  int m0 = mt * 128, n0 = nt * 128;
  LdRowBf16<128> la; la.tid = tid; la.p = A + (size_t)m0 * lda; la.ld = lda;
  f32x4 acc[4][4]; zero_acc<4>(acc);
  if constexpr (WBF) {
    LdRowBf16<128> lw; lw.tid = tid; lw.p = Wt + (size_t)n0 * K; lw.ld = K;
    gemm_kloop<4>(la, lw, K, acc, sW, sA);
  } else {
    LdKMajF32<128> lw; lw.tid = tid; lw.p = W + n0; lw.ld = 1024;
    gemm_kloop<4>(la, lw, K, acc, sW, sA);
  }
  int lane = tid & 63, w = tid >> 6, r = lane & 15, q = lane >> 4, wn = w >> 1, wm = w & 1;
#pragma unroll
  for (int mi = 0; mi < 4; mi++) {
    int m = m0 + wm * 64 + mi * 16 + r;
    float ss = 0.f;
#pragma unroll
    for (int ni = 0; ni < 4; ni++) {
      size_t off = (size_t)m * 1024 + n0 + wn * 64 + ni * 16 + q * 4;
      uint2 ho = *(const uint2*)(hb + off);
      f32x4 hv = acc[ni][mi];
      hv[0] += bflo(ho.x); hv[1] += bfhi(ho.x); hv[2] += bflo(ho.y); hv[3] += bfhi(ho.y);
      if (!dry) {
        if (final_out) *(f32x4*)(P.out + off) = hv;
        else *(uint2*)(hb + off) = make_uint2(pk2(hv[0], hv[1]), pk2(hv[2], hv[3]));
      }
      ss += hv[0] * hv[0] + hv[1] * hv[1] + hv[2] * hv[2] + hv[3] * hv[3];
    }
    ss += __shfl_xor(ss, 16); ss += __shfl_xor(ss, 32);
    if (q == 0 && !dry) partial[(size_t)m * 16 + nt * 2 + wn] = ss;
  }
}

NI void normed_tile(PRef P, const bf16_t* Wt, bf16_t* dst, int ldd, int mode, int mt, int nt, unsigned char* smem) {
  int tid = opaque_tid();
  bf16_t* sW = (bf16_t*)smem; bf16_t* sA = (bf16_t*)(smem + 18432);
  unsigned char* ws = P.ws;
  const float* partial = (const float*)(ws + OFF_PART);
  int m0 = mt * 128, n0 = nt * 128;
  LdRowBf16<128> la; la.tid = tid; la.p = (const bf16_t*)(ws + OFF_HB) + (size_t)m0 * 1024; la.ld = 1024;
  LdRowBf16<128> lw; lw.tid = tid; lw.p = Wt + (size_t)n0 * 1024; lw.ld = 1024;
  f32x4 acc[4][4]; zero_acc<4>(acc);
  gemm_kloop<4>(la, lw, 1024, acc, sW, sA);
  int lane = tid & 63, w = tid >> 6, r = lane & 15, q = lane >> 4, wn = w >> 1, wm = w & 1;
#pragma unroll
  for (int mi = 0; mi < 4; mi++) {
    int m = m0 + wm * 64 + mi * 16 + r;
    float rs = row_rstd(partial, m);
#pragma unroll
    for (int ni = 0; ni < 4; ni++) {
      f32x4 v = acc[ni][mi] * rs;
      if (mode == 1) {
#pragma unroll
        for (int j = 0; j < 4; j++) { float x = fmaxf(v[j], 0.f); v[j] = x * x; }
      }
      *(uint2*)(dst + (size_t)m * ldd + n0 + wn * 64 + ni * 16 + q * 4) = make_uint2(pk2(v[0], v[1]), pk2(v[2], v[3]));
    }
  }
}

NI void xattn_unit(PRef P, int l, int u, unsigned char* smem) {
  bf16_t* sK = (bf16_t*)smem;
  float* rkS = (float*)(smem + 36864);
  unsigned char* ws = P.ws;
  const bf16_t* xq = (const bf16_t*)(ws + OFF_XQ);
  const bf16_t* mk = (const bf16_t*)(ws + OFF_MEMK);
  const bf16_t* mvt = (const bf16_t*)(ws + OFF_MEMVT);
  bf16_t* xo = (bf16_t*)(ws + OFF_XO);
  const float* qn = P.in[28] + l * 256;
  const float* kn = P.in[29] + l * 256;
  int bh = u >> 5, qt = u & 31, b = bh >> 2, h = bh & 3;
  int tid = opaque_tid(), lane = tid & 63, w = tid >> 6, r = lane & 15, q = lane >> 4;
  int tok = b * SEQ + qt * 64 + w * 16 + r;
  __syncthreads();
  {
    const uint4* kr = (const uint4*)(mk + (size_t)(b * 256 + tid) * 1024 + h * 256);
    float ss = 0.f;
#pragma unroll 8
    for (int i = 0; i < 32; i++) {
      uint4 v = kr[i];
      ss += bflo(v.x) * bflo(v.x) + bfhi(v.x) * bfhi(v.x) + bflo(v.y) * bflo(v.y) + bfhi(v.y) * bfhi(v.y)
          + bflo(v.z) * bflo(v.z) + bfhi(v.z) * bfhi(v.z) + bflo(v.w) * bflo(v.w) + bfhi(v.w) * bfhi(v.w);
    }
    rkS[tid] = rsqrtf(ss * (1.f / 256.f) + 1e-6f);
  }
  f32x4 s[16];
#pragma unroll
  for (int a = 0; a < 16; a++) s[a] = (f32x4){0.f, 0.f, 0.f, 0.f};
  float qss = 0.f;
  int lrow = tid >> 3, lch = tid & 7;
#pragma unroll 1
  for (int dc = 0; dc < 4; dc++) {
    __syncthreads();
    {
      f32x4 ga = *(const f32x4*)(qn + dc * 64 + lch * 8), gb = *(const f32x4*)(qn + dc * 64 + lch * 8 + 4);
      f32x4 ka = *(const f32x4*)(kn + dc * 64 + lch * 8), kb2 = *(const f32x4*)(kn + dc * 64 + lch * 8 + 4);
      ga *= ka; gb *= kb2;
#pragma unroll
      for (int i = 0; i < 8; i++) {
        int row = lrow + 32 * i;
        uint4 v = *(const uint4*)(mk + (size_t)(b * 256 + row) * 1024 + h * 256 + dc * 64 + lch * 8);
        uint4 o;
        o.x = pk2(bflo(v.x) * ga[0], bfhi(v.x) * ga[1]); o.y = pk2(bflo(v.y) * ga[2], bfhi(v.y) * ga[3]);
        o.z = pk2(bflo(v.z) * gb[0], bfhi(v.z) * gb[1]); o.w = pk2(bflo(v.w) * gb[2], bfhi(v.w) * gb[3]);
        *(uint4*)(sK + row * 72 + lch * 8) = o;
      }
    }
    __syncthreads();
#pragma unroll
    for (int ks = 0; ks < 2; ks++) {
      union { bf16x8 v; uint4 u4; } qf;
      qf.u4 = *(const uint4*)(xq + (size_t)tok * 1024 + h * 256 + dc * 64 + ks * 32 + q * 8);
      qss += bflo(qf.u4.x) * bflo(qf.u4.x) + bfhi(qf.u4.x) * bfhi(qf.u4.x) + bflo(qf.u4.y) * bflo(qf.u4.y) + bfhi(qf.u4.y) * bfhi(qf.u4.y)
           + bflo(qf.u4.z) * bflo(qf.u4.z) + bfhi(qf.u4.z) * bfhi(qf.u4.z) + bflo(qf.u4.w) * bflo(qf.u4.w) + bfhi(qf.u4.w) * bfhi(qf.u4.w);
#pragma unroll
      for (int kt = 0; kt < 16; kt++) {
        bf16x8 a = *(const bf16x8*)(sK + (kt * 16 + r) * 72 + ks * 32 + q * 8);
        s[kt] = __builtin_amdgcn_mfma_f32_16x16x32_bf16(a, qf.v, s[kt], 0, 0, 0);
      }
    }
  }
  qss += __shfl_xor(qss, 16); qss += __shfl_xor(qss, 32);
  float rq = rsqrtf(qss * (1.f / 256.f) + 1e-6f) * (1.f / 16.f);
  float mx = -1e30f;
#pragma unroll
  for (int kt = 0; kt < 16; kt++) {
    f32x4 rk4 = *(const f32x4*)(rkS + kt * 16 + q * 4);
    s[kt] = s[kt] * rq * rk4;
    mx = fmaxf(mx, fmaxf(fmaxf(s[kt][0], s[kt][1]), fmaxf(s[kt][2], s[kt][3])));
  }
  mx = fmaxf(mx, __shfl_xor(mx, 16)); mx = fmaxf(mx, __shfl_xor(mx, 32));
  float lsum = 0.f;
  bf16x8 pb[8];
#pragma unroll
  for (int i = 0; i < 8; i++) {
    union { bf16x8 v; unsigned u4[4]; } t;
#pragma unroll
    for (int hf = 0; hf < 2; hf++) {
      float p0 = __expf(s[2 * i + hf][0] - mx), p1 = __expf(s[2 * i + hf][1] - mx);
      float p2 = __expf(s[2 * i + hf][2] - mx), p3 = __expf(s[2 * i + hf][3] - mx);
      lsum += (p0 + p1) + (p2 + p3);
      t.u4[hf * 2] = pk2(p0, p1); t.u4[hf * 2 + 1] = pk2(p2, p3);
    }
    pb[i] = t.v;
  }
  lsum += __shfl_xor(lsum, 16); lsum += __shfl_xor(lsum, 32);
  float inv = 1.f / lsum;
#pragma unroll 1
  for (int dc = 0; dc < 4; dc++) {
    __syncthreads();
    {
      int row0 = tid >> 5, ch = tid & 31;
#pragma unroll
      for (int i = 0; i < 8; i++) {
        int row = row0 + 8 * i;
        uint4 v = *(const uint4*)(mvt + (((size_t)b * 4 + h) * 256 + dc * 64 + row) * 256 + ch * 8);
        *(uint4*)(sK + row * 264 + ch * 8) = v;
      }
    }
    __syncthreads();
    f32x4 o[4];
#pragma unroll
    for (int dt = 0; dt < 4; dt++) o[dt] = (f32x4){0.f, 0.f, 0.f, 0.f};
#pragma unroll
    for (int i = 0; i < 8; i++)
#pragma unroll
      for (int dt = 0; dt < 4; dt++) {
        const bf16_t* vp = sK + (dt * 16 + r) * 264 + 32 * i + 4 * q;
        union { bf16x8 v; uint2 u2[2]; } av;
        av.u2[0] = *(const uint2*)vp; av.u2[1] = *(const uint2*)(vp + 16);
        o[dt] = __builtin_amdgcn_mfma_f32_16x16x32_bf16(av.v, pb[i], o[dt], 0, 0, 0);
      }
#pragma unroll
    for (int dt = 0; dt < 4; dt++) {
      int d = dc * 64 + dt * 16 + q * 4;
      *(uint2*)(xo + (size_t)tok * 1024 + h * 256 + d) =
          make_uint2(pk2(o[dt][0] * inv, o[dt][1] * inv), pk2(o[dt][2] * inv, o[dt][3] * inv));
    }
  }
}


DI bool xcd_tile(int n, int bid, int G, int MT, int NT, int& mt, int& nt) {
  int NTG = (NT + 7) >> 3, MTG = (MT + 7) >> 3;
  int slots = G >> 3;
  int slot = bid >> 3, xcd = bid & 7;
  int per = (64 + slots - 1) / slots;
  int gi = n / per, sub = n % per;
  int g = gi * 8 + xcd;
  if (g >= NTG * MTG) return false;
  int s = slot + sub * slots;
  mt = -1; nt = 0;
  if (s < 64) {
    int mtg = g / NTG, ntg = g % NTG;
    int m_ = mtg * 8 + (s >> 3), n_ = ntg * 8 + (s & 7);
    if (m_ < MT && n_ < NT) { mt = m_; nt = n_; }
  }
  return true;
}

#define XB_TMO      128
#define XB_XCNT(j)  (256  + 64 * (j))
#define XB_XSUB(j)  (1280 + 64 * (j))
#define XB_XGEN(j)  (2304 + 64 * (j))
#define XB_TOP      3328
#define XB_TOPGEN   3392
#define XCD_BAR_WORDS 3456
#define XB_SPIN_CAP (1u << 18)
#define LAS __attribute__((address_space(3)))

__device__ __forceinline__ unsigned xb_ld(unsigned* p)              { return __hip_atomic_load(p, __ATOMIC_RELAXED, __HIP_MEMORY_SCOPE_AGENT); }
__device__ __forceinline__ unsigned xb_add(unsigned* p, unsigned v) { return __hip_atomic_fetch_add(p, v, __ATOMIC_RELAXED, __HIP_MEMORY_SCOPE_AGENT); }
__device__ __forceinline__ unsigned xb_xcc_id() { return (unsigned)__builtin_amdgcn_s_getreg((3 << 11) | 20) & 0xFu; }
#define XB_SPIN(cond, bar) do { unsigned _sp = 0; while (cond) { __builtin_amdgcn_s_sleep(1); \
    if ((++_sp & 255u) == 0u) { if (xb_ld(&(bar)[XB_TMO])) break; if (_sp > XB_SPIN_CAP) { atomicAdd(&(bar)[XB_TMO], 1u); break; } } } } while (0)

struct XcdBarrier {
    unsigned* bar; unsigned x;
    volatile LAS unsigned* st;
};

__device__ __forceinline__ XcdBarrier xcd_barrier_post(unsigned* bar, volatile LAS unsigned* st) {
    XcdBarrier b; b.bar = bar; b.x = xb_xcc_id(); b.st = st;
    if (threadIdx.x == 0) (void)xb_add(&bar[XB_XCNT(b.x)], 1u);
    return b;
}
__device__ __forceinline__ void xcd_barrier_complete(unsigned* bar, unsigned x, unsigned& nloc, unsigned& nx) {
    const unsigned G = gridDim.x * gridDim.y * gridDim.z;
    unsigned sum, cnt, mine, sp = 0u;
    for (;;) {
        sum = 0u; cnt = 0u; mine = 0u;
#pragma unroll
        for (unsigned j = 0; j < 16; ++j) { const unsigned c = xb_ld(&bar[XB_XCNT(j)]); sum += c; cnt += (c > 0u) ? 1u : 0u; mine = (j == x) ? c : mine; }
        if (sum == G) break;
        __builtin_amdgcn_s_sleep(1);
        if ((++sp & 255u) == 0u) { if (xb_ld(&bar[XB_TMO])) break; if (sp > XB_SPIN_CAP) { atomicAdd(&bar[XB_TMO], 1u); break; } }
    }
    nloc = mine > 0u ? mine : 1u; nx = cnt > 0u ? cnt : 1u;
}

__device__ __forceinline__ void xcd_barrier(const XcdBarrier& b) {
    asm volatile("s_waitcnt vmcnt(0)" ::: "memory");
    __syncthreads();
    if (threadIdx.x == 0) {
        unsigned* bar = b.bar;
        __builtin_amdgcn_s_waitcnt(0);
        unsigned nloc = b.st[0], nx = b.st[1];
        if (nloc == 0u) { xcd_barrier_complete(bar, b.x, nloc, nx); b.st[0] = nloc; b.st[1] = nx; }
        const unsigned old = xb_add(&bar[XB_XSUB(b.x)], 1u);
        const unsigned gen = old / nloc;
        if (old + 1u == (gen + 1u) * nloc) {
            __builtin_amdgcn_fence(__ATOMIC_RELEASE, "agent");
            asm volatile("s_waitcnt vmcnt(0)" ::: "memory");
            const unsigned og = xb_add(&bar[XB_TOP], 1u);
            const unsigned tg = og / nx;
            if (og + 1u == (tg + 1u) * nx) xb_add(&bar[XB_TOPGEN], 1u);
            else XB_SPIN(xb_ld(&bar[XB_TOPGEN]) == tg, bar);
            __builtin_amdgcn_fence(__ATOMIC_ACQUIRE, "");
            xb_add(&bar[XB_XGEN(b.x)], 1u);
            asm volatile("s_waitcnt vmcnt(0)" ::: "memory");
        } else {
            XB_SPIN(xb_ld(&bar[XB_XGEN(b.x)]) == gen, bar);
            __builtin_amdgcn_fence(__ATOMIC_ACQUIRE, "");
            asm volatile("s_waitcnt vmcnt(0)" ::: "memory");
        }
    }
    __syncthreads();
}


#define OPQ(x) ({ int _t = (x); asm volatile("" : "+s"(_t)); _t; })
#ifndef DUP_P1
#define DUP_P1 0
#endif
#ifndef DUP_P2a
#define DUP_P2a 0
#endif
#ifndef DUP_P2b
#define DUP_P2b 0
#endif
#ifndef DUP_P2c
#define DUP_P2c 0
#endif
#ifndef DUP_P4
#define DUP_P4 0
#endif
#ifndef DUP_P5
#define DUP_P5 0
#endif
#ifndef DUP_P6
#define DUP_P6 0
#endif
#ifndef DUP_P7
#define DUP_P7 0
#endif
#ifndef DUP_P8
#define DUP_P8 0
#endif
#ifndef DUP_P9
#define DUP_P9 0
#endif
#ifndef DUP_P10
#define DUP_P10 0
#endif
__global__ void __launch_bounds__(256, 2) fwd_megakernel(Params Parg) {
  __shared__ __attribute__((aligned(16))) unsigned char smem[57344];
  cg::grid_group grid = cg::this_grid();
  const int G = gridDim.x, bid = blockIdx.x;
  PPtr Pk = (PPtr)__builtin_amdgcn_kernarg_segment_ptr();
#define P (*launder_p(Pk))
#define ws (P.ws)

  __shared__ uint4 xb_words;
  if (threadIdx.x == 0) xb_words = make_uint4(0u, 0u, 0u, 0u);
  __syncthreads();
  XcdBarrier xb = xcd_barrier_post((unsigned*)(ws + OFF_BAR), (volatile LAS unsigned*)&xb_words);
  for (int it = bid; it < 1760; it += G) wconv_job(P, it, smem);
  phase0(P, smem);
  for (int it = 1760 + bid; it < NWCONV; it += G) wconv_job(P, it, smem);
  xcd_barrier(xb);
  xcd_barrier(xb);
  const int probe_nd = *(volatile const int*)(ws + OFF_PROBE);
  if (probe_nd < 0) grid.sync();
#ifdef DUP_SYNC
  for (int i = 0; i < 20; i++) grid.sync();
#endif

#pragma unroll 1
  for (int l = 0; l < 2; l++) {
    const float* hsrc = l == 0 ? P.in[0] : P.out;
    const bf16_t* wbl = (const bf16_t*)P.out + (size_t)OPQ(l) * WO_LAYER;
    for (int rep = 0; rep < 1 + DUP_P1; rep++) {
      for (int it = bid; it < 512; it += G) hy_spectra_job(P, OPQ(l), it, smem);
      int mt, nt;
      for (int n = 0; xcd_tile(n, bid, G, 128, 31, mt, nt); n++) if (mt >= 0) inproj_tile(P, OPQ(l), hsrc, mt, nt, smem);
    }
    xcd_barrier(xb);
    for (int rep = 0; rep < 1 + DUP_P2a; rep++) for (int it = bid; it < 1024 + 1024 + 256; it += G) {
      if (it < 1024) attn_unit(P, it, smem);
      else if (it < 2048) gla_state_unit(P, OPQ(l), it - 1024, smem);
      else { int t = it - 2048; memkv_tile(P, OPQ(l), t >> 4, t & 15, smem); }
    }
    xcd_barrier(xb);
    for (int rep = 0; rep < 1 + DUP_P2b; rep++) for (int it = bid; it < 512 + 2048; it += G) {
      if (it < 512) gla_scan_unit(P, it, (rep < DUP_P2b * probe_nd));
      else { int t = it - 512; hy_conv_job(P, OPQ(l), t >> 2, t & 3, smem, (rep < DUP_P2b * probe_nd)); }
    }
    xcd_barrier(xb);
    for (int rep = 0; rep < 1 + DUP_P2c; rep++) for (int it = bid; it < 1024; it += G) gla_out_unit(P, OPQ(l), it, smem, (rep < DUP_P2c * probe_nd));
    xcd_barrier(xb);
    for (int rep = 0; rep < 1 + DUP_P4; rep++) { int mt, nt; for (int n = 0; xcd_tile(n, bid, G, 128, 8, mt, nt); n++) if (mt >= 0) merge_tile(P, OPQ(l), hsrc, mt, nt, smem); }
    xcd_barrier(xb);
    for (int rep = 0; rep < 1 + DUP_P5; rep++) { int mt, nt; for (int n = 0; xcd_tile(n, bid, G, 128, 8, mt, nt); n++) if (mt >= 0)
      resid_tile<true>(P, (const bf16_t*)(ws + OFF_MIXED), 1024, 1024, nullptr, wbl + WO_WOUT, false, mt, nt, smem, (rep < DUP_P5 * probe_nd)); }
    xcd_barrier(xb);
    for (int rep = 0; rep < 1 + DUP_P6; rep++) { int mt, nt; for (int n = 0; xcd_tile(n, bid, G, 128, 8, mt, nt); n++) if (mt >= 0)
      normed_tile(P, wbl + WO_WQ, (bf16_t*)(ws + OFF_XQ), 1024, 0, mt, nt, smem); }
    xcd_barrier(xb);
    for (int rep = 0; rep < 1 + DUP_P7; rep++) for (int it = bid; it < 1024; it += G) xattn_unit(P, OPQ(l), it, smem);
    xcd_barrier(xb);
    for (int rep = 0; rep < 1 + DUP_P8; rep++) { int mt, nt; for (int n = 0; xcd_tile(n, bid, G, 128, 8, mt, nt); n++) if (mt >= 0)
      resid_tile<true>(P, (const bf16_t*)(ws + OFF_XO), 1024, 1024, nullptr, wbl + WO_WO, false, mt, nt, smem, (rep < DUP_P8 * probe_nd)); }
    xcd_barrier(xb);
    for (int rep = 0; rep < 1 + DUP_P9; rep++) { int mt, nt; for (int n = 0; xcd_tile(n, bid, G, 128, 32, mt, nt); n++) if (mt >= 0)
      normed_tile(P, wbl + WO_W1, (bf16_t*)(ws + OFF_HID), 4096, 1, mt, nt, smem); }
    xcd_barrier(xb);
    for (int rep = 0; rep < 1 + DUP_P10; rep++) { int mt, nt; for (int n = 0; xcd_tile(n, bid, G, 128, 8, mt, nt); n++) if (mt >= 0)
      resid_tile<true>(P, (const bf16_t*)(ws + OFF_HID), 4096, 4096, nullptr, (l == 0 ? wbl + WO_W2 : (const bf16_t*)(ws + OFF_WB) + WS_W2L1), l == 1, mt, nt, smem, (rep < DUP_P10 * probe_nd)); }
    xcd_barrier(xb);
  }
}
#undef P
#undef ws

extern "C" void kernel_launch(void* const* d_in, const int* in_sizes, int n_in, void* d_out, int out_size, void* d_ws,
                              size_t ws_size, hipStream_t stream) {
  static int grid_blocks = 0;
  if (!grid_blocks) {
    int dev = 0, cus = 0, per_cu = 0;
    hipGetDevice(&dev);
    hipDeviceGetAttribute(&cus, hipDeviceAttributeMultiprocessorCount, dev);
    hipOccupancyMaxActiveBlocksPerMultiprocessor(&per_cu, fwd_megakernel, 256, 0);
    if (per_cu > 2) per_cu = 2;
    if (per_cu < 1) per_cu = 1;
    grid_blocks = cus * per_cu;
  }
  Params p{};
  for (int i = 0; i < 33; i++) p.in[i] = (const float*)d_in[i];
  p.out = (float*)d_out;
  p.ws = (unsigned char*)d_ws;
  (void)hipMemsetAsync((unsigned char*)d_ws + OFF_BAR, 0, 16384, stream);
  void* args[] = {&p};
  hipError_t e = hipLaunchCooperativeKernel((void*)fwd_megakernel, dim3(grid_blocks), dim3(256), args, 0, stream);
  if (e != hipSuccess) fprintf(stderr, "cooperative launch failed: %s (grid %d)\n", hipGetErrorString(e), grid_blocks);
}
```

```cpp
#include <hip/hip_runtime.h>
#include <hip/hip_cooperative_groups.h>
#include <cstdio>
namespace cg = cooperative_groups;

typedef __attribute__((ext_vector_type(8))) short bf16x8;
typedef __attribute__((ext_vector_type(4))) float f32x4;
typedef __attribute__((ext_vector_type(16))) float f32x16;
typedef unsigned short bf16_t;

#define DI __device__ __forceinline__
#ifndef NI
#define NI __device__ __forceinline__
#endif

constexpr int NT = 256;
constexpr int SEQ = 2048;
constexpr int TOK = 16384;
constexpr int NIN = 6944;
constexpr size_t MiB = 1ull << 20;

constexpr size_t OFF_SPEC = 0;
constexpr size_t OFF_PART = 17 * MiB;
constexpr size_t OFF_DECAY = 18 * MiB;
constexpr size_t OFF_H2 = 18 * MiB + 512 * 1024;
constexpr size_t OFF_TW = 19 * MiB + 512 * 1024;
constexpr size_t OFF_ROPE = OFF_TW + 32 * 1024;
constexpr size_t OFF_RMEM = OFF_ROPE + 8 * 1024;
constexpr size_t OFF_PROBE = OFF_RMEM + 8 * 1024;
constexpr size_t OFF_MEMK = 20 * MiB;
constexpr size_t OFF_MEMVT = 24 * MiB;
constexpr size_t OFF_BAR = 28 * MiB;
constexpr size_t OFF_Q = 29 * MiB;
constexpr size_t OFF_OA = OFF_Q;
constexpr size_t OFF_K = 45 * MiB;
constexpr size_t OFF_VT = 49 * MiB;
constexpr size_t OFF_HYT = 53 * MiB;
constexpr size_t OFF_GQ = 101 * MiB;
constexpr size_t OFF_GK = 109 * MiB;
constexpr size_t OFF_GV = 117 * MiB;
constexpr size_t OFF_GO = 133 * MiB;
constexpr size_t OFF_GLR = 149 * MiB;
constexpr size_t OFF_GST = 151 * MiB;
constexpr size_t OFF_MIXED = 151 * MiB;
constexpr size_t OFF_HB = 183 * MiB;
constexpr size_t OFF_WB = 215 * MiB;
constexpr size_t OFF_XQ = 29 * MiB;
constexpr size_t OFF_XO = 61 * MiB;
constexpr size_t OFF_HID = 29 * MiB;
constexpr size_t WS_WIN = 7110656;
constexpr size_t WS_W2L1 = 2 * WS_WIN;
constexpr size_t WO_WOUT = 0;
constexpr size_t WO_WQ = 1048576;
constexpr size_t WO_W1 = 2097152;
constexpr size_t WO_W2 = 6291456;
constexpr size_t WO_WK = 10485760;
constexpr size_t WO_WV = WO_WK + 1048576;
constexpr size_t WO_WO = WO_WV + 1048576;
constexpr size_t WO_BR = WO_WO + 1048576;
constexpr size_t WO_LAYER = WO_BR + 1572864;
constexpr int NWL = 128 + 128 + 512 + 512 + 128 * 3 + 192;
constexpr int NWCONV = 2 * 880 + 2 * NWL;

struct Params {
  const float* in[33];
  float* out;
  unsigned char* ws;
};
typedef const __attribute__((address_space(4))) Params& PRef;
typedef const __attribute__((address_space(4))) Params* PPtr;
__device__ __forceinline__ PPtr launder_p(PPtr p) { asm volatile("" : "+s"(p)); return p; }

DI int opaque_tid() { int t = threadIdx.x; asm volatile("" : "+v"(t)); return t; }
typedef __bf16 bf2_t __attribute__((ext_vector_type(2)));
typedef float f2_t __attribute__((ext_vector_type(2)));
DI unsigned f2bf(float f) { __bf16 h = (__bf16)f; return (unsigned)__builtin_bit_cast(unsigned short, h); }
DI float bf2f(unsigned h) { return __uint_as_float(h << 16); }
DI unsigned pk2(float a, float b) { f2_t v = {a, b}; return __builtin_bit_cast(unsigned, __builtin_convertvector(v, bf2_t)); }
DI float bflo(unsigned u) { return __uint_as_float(u << 16); }
DI float bfhi(unsigned u) { return __uint_as_float(u & 0xffff0000u); }
DI float sigmoidf_(float x) { return 1.f / (1.f + __expf(-x)); }

DI float row_rstd(const float* partial, int m) {
  const float4* p = (const float4*)(partial + (size_t)m * 16);
  float4 a = p[0], b = p[1], c = p[2], d = p[3];
  float s = a.x + a.y + a.z + a.w + b.x + b.y + b.z + b.w + c.x + c.y + c.z + c.w + d.x + d.y + d.z + d.w;
  return rsqrtf(s * (1.f / 1024.f) + 1e-6f);
}

DI int swz_off(int row, int k) {
  int st = (row >> 4) * 2 + (k >> 5);
  int ob = (row & 15) * 64 + (k & 31) * 2;
  return (st * 1024 + (ob ^ (((ob >> 9) & 1) << 5))) >> 1;
}
DI int lds_off(bool swz, int row, int k) { return swz ? swz_off(row, k) : row * 72 + k; }

template <int ROWS, bool SWZ = true> struct LdRowF32 {
  static constexpr int NV = ROWS / 16;
  const float* p; int ld; const float* gain; int tid; f32x4 r[NV];
  DI void load(int k0) {
    int c4 = tid & 15, r0 = tid >> 4;
    f32x4 g = (f32x4){1.f, 1.f, 1.f, 1.f};
    if (gain) g = *(const f32x4*)(gain + k0 + c4 * 4);
#pragma unroll
    for (int i = 0; i < NV; i++) {
      f32x4 v = *(const f32x4*)(p + (unsigned)((r0 + 16 * i) * ld + k0 + c4 * 4));
      r[i] = v * g;
    }
  }
  DI void store(bf16_t* s) {
    int c4 = tid & 15, r0 = tid >> 4;
#pragma unroll
    for (int i = 0; i < NV; i++)
      *(uint2*)(s + lds_off(SWZ, r0 + 16 * i, c4 * 4)) = make_uint2(pk2(r[i][0], r[i][1]), pk2(r[i][2], r[i][3]));
  }
};

template <int ROWS, bool SWZ = true> struct LdRowBf16 {
  static constexpr int NV = ROWS / 32;
  const bf16_t* p; int ld; int tid; uint4 r[NV];
  DI void load(int k0) {
    int ch = tid & 7, r0 = tid >> 3;
#pragma unroll
    for (int i = 0; i < NV; i++) r[i] = *(const uint4*)(p + (unsigned)((r0 + 32 * i) * ld + k0 + ch * 8));
  }
  DI void store(bf16_t* s) {
    int ch = tid & 7, r0 = tid >> 3;
#pragma unroll
    for (int i = 0; i < NV; i++) *(uint4*)(s + lds_off(SWZ, r0 + 32 * i, ch * 8)) = r[i];
  }
};

template <int COLS, bool SWZ = true> struct LdKMajF32 {
  static constexpr int KPT = COLS / 16;
  static constexpr int KG = 64 / KPT;
  const float* p; int ld; int tid; const float* gain = nullptr; int ncol = COLS; f32x4 r[KPT];
  DI void load(int k0) {
    int kg = tid % KG, ng = tid / KG;
    int c0 = ng * 4 < ncol ? ng * 4 : 0;
#pragma unroll
    for (int i = 0; i < KPT; i++) {
      f32x4 v = *(const f32x4*)(p + (unsigned)((k0 + kg * KPT + i) * ld + c0));
      if (gain) v *= gain[k0 + kg * KPT + i];
      r[i] = v;
    }
  }
  DI void store(bf16_t* s) {
    int kg = tid % KG, ng = tid / KG;
#pragma unroll
    for (int c = 0; c < 4; c++) {
      if constexpr (KPT == 8) {
        uint4 v = make_uint4(pk2(r[0][c], r[1][c]), pk2(r[2][c], r[3][c]), pk2(r[4][c], r[5][c]), pk2(r[6][c], r[7][c]));
        *(uint4*)(s + lds_off(SWZ, ng * 4 + c, kg * 8)) = v;
      } else {
        uint2 v = make_uint2(pk2(r[0][c], r[1][c]), pk2(r[2][c], r[3][c]));
        *(uint2*)(s + lds_off(SWZ, ng * 4 + c, kg * 4)) = v;
      }
    }
  }
};

DI unsigned getbf(uint2 v, int c) { return c == 0 ? (v.x & 0xffffu) : c == 1 ? (v.x >> 16) : c == 2 ? (v.y & 0xffffu) : (v.y >> 16); }

template <int COLS, bool SWZ = true> struct LdKMajBf16 {
  static constexpr int KPT = COLS / 16;
  static constexpr int KG = 64 / KPT;
  const bf16_t* p; int ld; int tid; uint2 r[KPT];
  DI void load(int k0) {
    int kg = tid % KG, ng = tid / KG;
#pragma unroll
    for (int i = 0; i < KPT; i++) r[i] = *(const uint2*)(p + (unsigned)((k0 + kg * KPT + i) * ld + ng * 4));
  }
  DI void store(bf16_t* s) {
    int kg = tid % KG, ng = tid / KG;
#pragma unroll
    for (int c = 0; c < 4; c++) {
      if constexpr (KPT == 8) {
        uint4 v = make_uint4(getbf(r[0], c) | (getbf(r[1], c) << 16), getbf(r[2], c) | (getbf(r[3], c) << 16),
                             getbf(r[4], c) | (getbf(r[5], c) << 16), getbf(r[6], c) | (getbf(r[7], c) << 16));
        *(uint4*)(s + lds_off(SWZ, ng * 4 + c, kg * 8)) = v;
      } else {
        uint2 v = make_uint2(getbf(r[0], c) | (getbf(r[1], c) << 16), getbf(r[2], c) | (getbf(r[3], c) << 16));
        *(uint2*)(s + lds_off(SWZ, ng * 4 + c, kg * 4)) = v;
      }
    }
  }
};

template <int MI> DI void mma_step(const bf16_t* sW, const bf16_t* sA, f32x4 (&acc)[4][MI], int tid) {
  int lane = tid & 63, w = tid >> 6, r = lane & 15, q = lane >> 4;
  int wn = w >> 1, wm = w & 1;
  int lane_off = ((r * 64 + q * 16) ^ ((r >> 3) << 5)) >> 1;
  const bf16_t* pw = sW + wn * 4 * 1024 + lane_off;
  const bf16_t* pa = sA + wm * MI * 1024 + lane_off;
#pragma unroll
  for (int kk = 0; kk < 2; kk++) {
    bf16x8 a[4], b[MI];
#pragma unroll
    for (int ni = 0; ni < 4; ni++) a[ni] = *(const bf16x8*)(pw + (ni * 2 + kk) * 512);
#pragma unroll
    for (int mi = 0; mi < MI; mi++) b[mi] = *(const bf16x8*)(pa + (mi * 2 + kk) * 512);
#pragma unroll
    for (int ni = 0; ni < 4; ni++)
#pragma unroll
      for (int mi = 0; mi < MI; mi++) acc[ni][mi] = __builtin_amdgcn_mfma_f32_16x16x32_bf16(a[ni], b[mi], acc[ni][mi], 0, 0, 0);
  }
}

template <int MI> DI void mma_step_plain(const bf16_t* sW, const bf16_t* sA, f32x4 (&acc)[4][MI], int tid) {
  int lane = tid & 63, w = tid >> 6, r = lane & 15, q = lane >> 4;
  int wn = w >> 1, wm = w & 1;
#pragma unroll
  for (int kk = 0; kk < 2; kk++) {
    bf16x8 a[4], b[MI];
#pragma unroll
    for (int ni = 0; ni < 4; ni++) a[ni] = *(const bf16x8*)(sW + (wn * 64 + ni * 16 + r) * 72 + kk * 32 + q * 8);
#pragma unroll
    for (int mi = 0; mi < MI; mi++) b[mi] = *(const bf16x8*)(sA + (wm * 16 * MI + mi * 16 + r) * 72 + kk * 32 + q * 8);
#pragma unroll
    for (int ni = 0; ni < 4; ni++)
#pragma unroll
      for (int mi = 0; mi < MI; mi++) acc[ni][mi] = __builtin_amdgcn_mfma_f32_16x16x32_bf16(a[ni], b[mi], acc[ni][mi], 0, 0, 0);
  }
}
template <int MI, class LA, class LW> DI void gemm_kloop_plain(LA& la, LW& lw, int K, f32x4 (&acc)[4][MI], bf16_t* sW, bf16_t* sA) {
  la.load(0); lw.load(0);
  for (int k0 = 0; k0 < K; k0 += 64) {
    __syncthreads();
    la.store(sA); lw.store(sW);
    __syncthreads();
    if (k0 + 64 < K) { la.load(k0 + 64); lw.load(k0 + 64); }
    mma_step_plain<MI>(sW, sA, acc, la.tid);
  }
}
template <int MI, class LA, class LW> DI void gemm_kloop(LA& la, LW& lw, int K, f32x4 (&acc)[4][MI], bf16_t* sW, bf16_t* sA) {
  la.load(0); lw.load(0);
  for (int k0 = 0; k0 < K; k0 += 64) {
    __syncthreads();
    la.store(sA); lw.store(sW);
    __syncthreads();
    if (k0 + 64 < K) { la.load(k0 + 64); lw.load(k0 + 64); }
    mma_step<MI>(sW, sA, acc, la.tid);
  }
}

template <int MI, class LA, class LW> DI void gemm_kloop2(LA& la, LW& lw, int K, f32x4 (&acc)[4][MI], bf16_t* sW, bf16_t* sA) {
  LA la1 = la; LW lw1 = lw;
  la.load(0); lw.load(0);
  la1.load(64); lw1.load(64);
  for (int k0 = 0; k0 < K; k0 += 128) {
    __syncthreads();
    la.store(sA); lw.store(sW);
    __syncthreads();
    if (k0 + 128 < K) { la.load(k0 + 128); lw.load(k0 + 128); }
    mma_step<MI>(sW, sA, acc, la.tid);
    __syncthreads();
    la1.store(sA); lw1.store(sW);
    __syncthreads();
    if (k0 + 192 < K) { la1.load(k0 + 192); lw1.load(k0 + 192); }
    mma_step<MI>(sW, sA, acc, la.tid);
  }
}

template <int MI> DI void zero_acc(f32x4 (&acc)[4][MI]) {
#pragma unroll
  for (int a = 0; a < 4; a++)
#pragma unroll
    for (int b = 0; b < MI; b++) acc[a][b] = (f32x4){0.f, 0.f, 0.f, 0.f};
}

DI float2 cmul(float2 a, float2 b) { return make_float2(a.x * b.x - a.y * b.y, a.x * b.y + a.y * b.x); }
DI void fft_fill_twl(float2* twl, const float2* __restrict__ tw, int tid) {
#pragma unroll
  for (int i = 0; i < 4; i++) {
    int j = tid + 256 * i;
    float s, c; sincospif((float)j * (1.0f / 512.0f), &s, &c);
    twl[j] = make_float2(c, -s);
  }
  if (tid < 4) { float s, c; sincospif((float)tid * (1.0f / 2048.0f), &s, &c); twl[1024 + tid] = make_float2(c, -s); }
}
DI int bi(int x) { return x + (x >> 4); }
DI void dft4(float2 x0, float2 x1, float2 x2, float2 x3, float2& y0, float2& y1, float2& y2, float2& y3) {
  float2 v0 = make_float2(x0.x + x2.x, x0.y + x2.y), v1 = make_float2(x0.x - x2.x, x0.y - x2.y);
  float2 v2 = make_float2(x1.x + x3.x, x1.y + x3.y), dd = make_float2(x1.x - x3.x, x1.y - x3.y);
  float2 v3 = make_float2(dd.y, -dd.x);
  y0 = make_float2(v0.x + v2.x, v0.y + v2.y);
  y1 = make_float2(v1.x + v3.x, v1.y + v3.y);
  y2 = make_float2(v0.x - v2.x, v0.y - v2.y);
  y3 = make_float2(v1.x - v3.x, v1.y - v3.y);
}
DI void fft4096(float2* buf, const float2* __restrict__ tw, const float2* twl, int tid) {
#pragma unroll 1
  for (int lp = 0; lp < 12; lp += 4) {
    int p = 1 << lp;
    int sh = 8 - lp;
    int k = tid & (p - 1);
    int j = ((tid - k) << 4) + k;
    float2 u[16];
#pragma unroll
    for (int n = 0; n < 16; n++) u[n] = buf[bi(tid + 256 * n)];
    if (lp == 4) {
#pragma unroll
      for (int n = 1; n < 16; n++) { int m = (k * n) << sh; u[n] = cmul(u[n], twl[m >> 2]); }
    } else if (lp == 8) {
#pragma unroll
      for (int n = 1; n < 16; n++) { int m = k * n; u[n] = cmul(u[n], cmul(twl[m >> 2], twl[1024 + (m & 3)])); }
    }
    const float c1 = 0.92387953251128674f, s1 = 0.38268343236508977f, h = 0.70710678118654752f;
#pragma unroll
    for (int bq = 0; bq < 4; bq++) {
      float2 r0, r1, r2, r3;
      dft4(u[bq], u[4 + bq], u[8 + bq], u[12 + bq], r0, r1, r2, r3);
      if (bq == 1) { r1 = cmul(r1, make_float2(c1, -s1)); r2 = cmul(r2, make_float2(h, -h)); r3 = cmul(r3, make_float2(s1, -c1)); }
      if (bq == 2) { r1 = cmul(r1, make_float2(h, -h)); r2 = make_float2(r2.y, -r2.x); r3 = cmul(r3, make_float2(-h, -h)); }
      if (bq == 3) { r1 = cmul(r1, make_float2(s1, -c1)); r2 = cmul(r2, make_float2(-h, -h)); r3 = cmul(r3, make_float2(-c1, s1)); }
      u[bq] = r0; u[4 + bq] = r1; u[8 + bq] = r2; u[12 + bq] = r3;
    }
    __syncthreads();
#pragma unroll
    for (int c = 0; c < 4; c++) {
      float2 r0, r1, r2, r3;
      dft4(u[4 * c], u[4 * c + 1], u[4 * c + 2], u[4 * c + 3], r0, r1, r2, r3);
      buf[bi(j + (c) * p)] = r0; buf[bi(j + (c + 4) * p)] = r1; buf[bi(j + (c + 8) * p)] = r2; buf[bi(j + (c + 12) * p)] = r3;
    }
    __syncthreads();
  }
}

NI void phase0(PRef P, unsigned char* smem) {
  unsigned char* ws = P.ws;
  float* partial = (float*)(ws + OFF_PART);
  float* rmem = (float*)(ws + OFF_RMEM);
  float2* tw = (float2*)(ws + OFF_TW);
  float2* rope = (float2*)(ws + OFF_ROPE);
  float* h2 = (float*)(ws + OFF_H2);
  int tid = opaque_tid();
  int gtid = blockIdx.x * NT + tid, gsz = gridDim.x * NT;
  if (gtid == 0) *(int*)(P.ws + OFF_PROBE) = 1;
  for (int i = gtid; i < 4096; i += gsz) {
    float s, c; sincospif(2.0f * (float)i / 4096.0f, &s, &c);
    tw[i] = make_float2(c, -s);
  }
  for (int i = gtid; i < 1024; i += gsz) {
    int pos = i >> 4, f = i & 15;
    float inv = powf(10000.0f, -(float)f / 16.0f);
    float a = (float)pos * inv;
    rope[i] = make_float2(cosf(a), sinf(a));
  }
  int lane = tid & 63;
  int gw = gtid >> 6, nw = gsz >> 6;
  for (int row = gw; row < TOK + 2048; row += nw) {
    const float* src = row < TOK ? P.in[0] + (size_t)row * 1024 : P.in[1] + (size_t)(row - TOK) * 1024;
    float ss = 0.f;
#pragma unroll
    for (int i = 0; i < 4; i++) {
      float4 v = *(const float4*)(src + i * 256 + lane * 4);
      ss += v.x * v.x + v.y * v.y + v.z * v.z + v.w * v.w;
      if (row < TOK) *(uint2*)((bf16_t*)(P.ws + OFF_HB) + (size_t)row * 1024 + i * 256 + lane * 4) = make_uint2(pk2(v.x, v.y), pk2(v.z, v.w));
    }
#pragma unroll
    for (int o = 32; o > 0; o >>= 1) ss += __shfl_xor(ss, o);
    if (row < TOK) {
      if (lane < 16) partial[(size_t)row * 16 + lane] = lane == 0 ? ss : 0.f;
    } else if (lane == 0) rmem[row - TOK] = rsqrtf(ss * (1.f / 1024.f) + 1e-6f);
  }
  for (int it = gw; it < 2 * SEQ; it += nw) {
    int l = it >> 11, t = it & 2047;
    const float* w1 = P.in[7] + (size_t)l * 33 * 64;
    const float* b1 = P.in[8] + l * 64;
    const float* w2 = P.in[9] + (size_t)l * 64 * 64;
    const float* b2 = P.in[10] + l * 64;
    const float* fr = P.in[13] + l * 128;
    float zv = 0.f;
    if (lane == 0) zv = (float)t / 2047.0f;
    else if (lane < 33) {
      int kb = (lane - 1) & 15;
      float fk = 1e-4f + (float)kb * ((15.0f - 1e-4f) / 15.0f);
      float wv = 2.0f * 3.14159265358979323846f * (float)t / 2048.0f;
      float a = wv * fk;
      zv = lane <= 16 ? cosf(a) : -sinf(a);
    }
    float acc = b1[lane];
    for (int k = 0; k < 33; k++) acc += __shfl(zv, k) * w1[k * 64 + lane];
    float h1 = sinf(fr[lane] * acc);
    float acc2 = b2[lane];
    for (int k = 0; k < 64; k++) acc2 += __shfl(h1, k) * w2[k * 64 + lane];
    h2[(size_t)it * 64 + lane] = sinf(fr[64 + lane] * acc2);
  }
}

NI void hy_spectra_job(PRef P, int l, int c, unsigned char* smem) {
  float2* buf = (float2*)smem;
  float* w3s = (float*)(smem + 49664);
  float* red = (float*)(smem + 49664 + 1024);
  unsigned char* ws = P.ws;
  const float* h2 = (const float*)(ws + OFF_H2) + (size_t)l * SEQ * 64;
  const float2* tw = (const float2*)(ws + OFF_TW);
  float2* spec = (float2*)(ws + OFF_SPEC);
  const float* w3 = P.in[11] + (size_t)l * 64 * 2048;
  const float* b3 = P.in[12] + (size_t)l * 2048;
  int tid = opaque_tid();
  float2* twl = (float2*)(smem + 40960);
  __syncthreads();
  fft_fill_twl(twl, tw, tid);
  {
    int j = tid >> 6, k = tid & 63;
    w3s[j * 64 + k] = w3[(size_t)k * 2048 + j * 512 + c];
  }
  __syncthreads();
  float bb[4];
#pragma unroll
  for (int j = 0; j < 4; j++) bb[j] = b3[j * 512 + c];
  const float la = -4.605170185988091f / 0.3f, lb = -4.605170185988091f / 1.5f;
  float delta = fabsf(la + (lb - la) * ((float)c / 511.0f));
  float n0 = 0.f, n1 = 0.f;
#pragma unroll 1
  for (int i = 0; i < 8; i++) {
    int t = tid + 256 * i;
    float v[4] = {bb[0], bb[1], bb[2], bb[3]};
    const float4* hr = (const float4*)(h2 + (size_t)t * 64);
#pragma unroll 4
    for (int k4 = 0; k4 < 16; k4++) {
      float4 hv = hr[k4];
#pragma unroll
      for (int j = 0; j < 4; j++) {
        const float* wj = w3s + j * 64 + k4 * 4;
        v[j] += hv.x * wj[0] + hv.y * wj[1] + hv.z * wj[2] + hv.w * wj[3];
      }
    }
    float win = __expf(-((float)t / 2047.0f) * delta);
#pragma unroll
    for (int j = 0; j < 4; j++) v[j] *= win;
    buf[bi(t)] = make_float2(v[0], v[2]);
    n0 += fabsf(v[0]); n1 += fabsf(v[2]);
    if (t >= 1) { buf[bi(4096 - t)] = make_float2(v[1], v[3]); n0 += fabsf(v[1]); n1 += fabsf(v[3]); }
    else buf[bi(2048)] = make_float2(0.f, 0.f);
  }
#pragma unroll
  for (int o = 32; o > 0; o >>= 1) { n0 += __shfl_xor(n0, o); n1 += __shfl_xor(n1, o); }
  if ((tid & 63) == 0) { red[(tid >> 6)] = n0; red[4 + (tid >> 6)] = n1; }
  __syncthreads();
  float inv0 = 0.5f / (red[0] + red[1] + red[2] + red[3] + 1e-6f);
  float inv1 = 0.5f / (red[4] + red[5] + red[6] + red[7] + 1e-6f);
  fft4096(buf, tw, twl, tid);
#pragma unroll 2
  for (int i = 0; i < 16; i++) {
    int k = tid + 256 * i;
    float2 a = buf[bi(k)], b = buf[bi((4096 - k) & 4095)];
    if (k <= 2048) {
      spec[((size_t)c * 2 + 0) * 2049 + k] = make_float2((a.x + b.x) * inv0, (a.y - b.y) * inv0);
      spec[((size_t)c * 2 + 1) * 2049 + k] = make_float2((a.y + b.y) * inv1, -(a.x - b.x) * inv1);
    }
  }
  __syncthreads();
}

DI float hy_sc(const bf16_t* row, int t, float w0, float w1, float w2) {
  float a = t > 0 ? bf2f(row[t - 1]) : 0.f;
  float b = bf2f(row[t]);
  float d = t < SEQ - 1 ? bf2f(row[t + 1]) : 0.f;
  return w0 * a + w1 * b + w2 * d;
}
NI void hy_conv_job(PRef P, int l, int c, int pr, unsigned char* smem, bool dry) {
  float2* buf = (float2*)smem;
  unsigned char* ws = P.ws;
  const float2* tw = (const float2*)(ws + OFF_TW);
  const float2* H0 = (const float2*)(ws + OFF_SPEC) + ((size_t)c * 2) * 2049;
  const float2* H1 = H0 + 2049;
  bf16_t* hyT = (bf16_t*)(ws + OFF_HYT);
  const float* cw = P.in[6] + (size_t)l * 3 * 1536;
  const float* skip = P.in[14] + (size_t)l * 1024;
  int tid = opaque_tid();
  int b0 = 2 * pr, b1 = 2 * pr + 1;
  bf16_t* rv0 = hyT + ((size_t)b0 * 1536 + c) * SEQ;
  bf16_t* rv1 = hyT + ((size_t)b1 * 1536 + c) * SEQ;
  const bf16_t* rx10 = rv0 + (size_t)512 * SEQ; const bf16_t* rx11 = rv1 + (size_t)512 * SEQ;
  const bf16_t* rx20 = rv0 + (size_t)1024 * SEQ; const bf16_t* rx21 = rv1 + (size_t)1024 * SEQ;
  float wv0 = cw[c], wv1 = cw[1536 + c], wv2 = cw[3072 + c];
  float wa0 = cw[512 + c], wa1 = cw[1536 + 512 + c], wa2 = cw[3072 + 512 + c];
  float wb0 = cw[1024 + c], wb1 = cw[1536 + 1024 + c], wb2 = cw[3072 + 1024 + c];
  float sk0 = skip[c], sk1 = skip[512 + c];
  float va[8], vb[8];
  float2* twl = (float2*)(smem + 40960);
  __syncthreads();
  fft_fill_twl(twl, tw, tid);
#pragma unroll
  for (int i = 0; i < 8; i++) {
    int t = tid + 256 * i;
    va[i] = hy_sc(rv0, t, wv0, wv1, wv2);
    vb[i] = hy_sc(rv1, t, wv0, wv1, wv2);
    buf[bi(t)] = make_float2(va[i], vb[i]);
    buf[bi(t + 2048)] = make_float2(0.f, 0.f);
  }
  __syncthreads();
  fft4096(buf, tw, twl, tid);
  for (int i = 0; i < 16; i++) {
    int k = tid + 256 * i;
    float2 hk = k <= 2048 ? H0[k] : H0[4096 - k];
    if (k > 2048) hk.y = -hk.y;
    float2 w = cmul(buf[bi(k)], hk);
    buf[bi(k)] = make_float2(w.x, -w.y);
  }
  __syncthreads();
  fft4096(buf, tw, twl, tid);
  const float sc = 1.0f / 4096.0f;
#pragma unroll
  for (int i = 0; i < 8; i++) {
    int t = tid + 256 * i;
    float2 y = buf[bi(t)];
    float y0 = y.x * sc + va[i] * sk0;
    float y1 = -y.y * sc + vb[i] * sk0;
    float z0 = hy_sc(rx10, t, wa0, wa1, wa2) * y0;
    float z1 = hy_sc(rx11, t, wa0, wa1, wa2) * y1;
    va[i] = z0; vb[i] = z1;
    buf[bi(t)] = make_float2(z0, z1);
    buf[bi(t + 2048)] = make_float2(0.f, 0.f);
  }
  __syncthreads();
  fft4096(buf, tw, twl, tid);
  for (int i = 0; i < 16; i++) {
    int k = tid + 256 * i;
    float2 hk = k <= 2048 ? H1[k] : H1[4096 - k];
    if (k > 2048) hk.y = -hk.y;
    float2 w = cmul(buf[bi(k)], hk);
    buf[bi(k)] = make_float2(w.x, -w.y);
  }
  __syncthreads();
  fft4096(buf, tw, twl, tid);
#pragma unroll
  for (int i = 0; i < 8; i++) {
    int t = tid + 256 * i;
    float2 y = buf[bi(t)];
    float y0 = y.x * sc + va[i] * sk1;
    float y1 = -y.y * sc + vb[i] * sk1;
    float o0 = hy_sc(rx20, t, wb0, wb1, wb2) * y0;
    float o1 = hy_sc(rx21, t, wb0, wb1, wb2) * y1;
    va[i] = o0; vb[i] = o1;
  }
  __syncthreads();
#pragma unroll
  for (int i = 0; i < 8; i++) {
    int t = tid + 256 * i;
    if (!dry) { rv0[t] = (bf16_t)f2bf(va[i]); rv1[t] = (bf16_t)f2bf(vb[i]); }
  }
}


NI void wconv_job(PRef P, int it, unsigned char* smem) {
  int tid = opaque_tid();
  bf16_t* sW = (bf16_t*)smem;
  unsigned char* ws = P.ws;
  const float* src; const float* gain = nullptr; bf16_t* dst;
  int K = 1024, N = 1024, kt, nt, l;
  if (it < 1760) {
    l = it >= 880 ? 1 : 0; int r = it - l * 880;
    src = P.in[3] + (size_t)l * 1024 * NIN; gain = P.in[2] + l * 1024; dst = (bf16_t*)(ws + OFF_WB) + (size_t)l * WS_WIN; N = NIN; nt = r % 55; kt = r / 55;
  } else {
    int r = it - 1760; l = r >= NWL ? 1 : 0; r -= l * NWL;
    bf16_t* wo = (bf16_t*)P.out + (size_t)l * WO_LAYER;
    if (r < 128) { src = P.in[21] + (size_t)l * 1024 * 1024; dst = wo + WO_WOUT; nt = r & 7; kt = r >> 3; }
    else if (r < 256) { r -= 128; src = P.in[24] + (size_t)l * 1024 * 1024; gain = P.in[22] + l * 1024; dst = wo + WO_WQ; nt = r & 7; kt = r >> 3; }
    else if (r < 768) { r -= 256; src = P.in[31] + (size_t)l * 1024 * 4096; gain = P.in[30] + l * 1024; dst = wo + WO_W1; N = 4096; nt = r & 31; kt = r >> 5; }
    else if (r < 1280) { r -= 768; src = P.in[32] + (size_t)l * 4096 * 1024; dst = l == 0 ? wo + WO_W2 : (bf16_t*)(ws + OFF_WB) + WS_W2L1; K = 4096; nt = r & 7; kt = r >> 3; }
    else if (r < 1280 + 384) {
      r -= 1280; int which = r >> 7, rr = r & 127; nt = rr & 7; kt = rr >> 3;
      if (which == 0) { src = P.in[25]; dst = wo + WO_WK; gain = P.in[23] + l * 1024; }
      else if (which == 1) { src = P.in[26]; dst = wo + WO_WV; gain = P.in[23] + l * 1024; }
      else { src = P.in[27]; dst = wo + WO_WO; }
      src += (size_t)l * 1024 * 1024;
    } else {
      r -= 1280 + 384; int br = r >> 6, rr = r & 63; K = 512; nt = rr & 7; kt = rr >> 3;
      src = (br == 0 ? P.in[18] : br == 1 ? P.in[19] : P.in[20]) + (size_t)l * 512 * 1024; dst = wo + WO_BR + (size_t)br * 524288;
    }
  }
  int n0 = nt * 128, k0 = kt * 64;
  int valid = N - n0 < 128 ? N - n0 : 128;
  LdKMajF32<128> lw; lw.tid = tid; lw.p = src + n0; lw.ld = N; lw.gain = gain; lw.ncol = valid;
  lw.load(k0);
  __syncthreads();
  lw.store(sW);
  __syncthreads();
  int n = tid >> 1, half = tid & 1;
  if (n < valid) {
#pragma unroll
    for (int e = 0; e < 4; e++)
      *(uint4*)(dst + (size_t)(n0 + n) * K + k0 + half * 32 + e * 8) = *(const uint4*)(sW + swz_off(n, half * 32 + e * 8));
  }
}

NI void inproj_tile(PRef P, int l, const float* hsrc, int mt, int nt, unsigned char* smem) {
  int tid = opaque_tid();
  bf16_t* sW = (bf16_t*)smem; bf16_t* sA = (bf16_t*)(smem + 18432);
  unsigned char* ws = P.ws;
  const float* partial = (const float*)(ws + OFF_PART);
  int m0 = mt * 128, n0 = nt * 128;
  LdRowBf16<128> la; la.tid = tid; la.p = (const bf16_t*)(ws + OFF_HB) + (size_t)m0 * 1024; la.ld = 1024;
  LdRowBf16<128> lw; lw.tid = tid; lw.p = (const bf16_t*)(ws + OFF_WB) + (size_t)l * WS_WIN + (size_t)n0 * 1024; lw.ld = 1024;
  f32x4 acc[4][4]; zero_acc<4>(acc);
  gemm_kloop<4>(la, lw, 1024, acc, sW, sA);
  int lane = tid & 63, w = tid >> 6, r = lane & 15, q = lane >> 4, wn = w >> 1, wm = w & 1;
#pragma unroll
  for (int mi = 0; mi < 4; mi++) {
    int m = m0 + wm * 64 + mi * 16 + r;
    float rs = row_rstd(partial, m);
#pragma unroll
    for (int ni = 0; ni < 4; ni++) acc[ni][mi] *= rs;
  }
  if (nt <= 4) {
    const float* gn = (nt < 4 ? P.in[4] : P.in[5]) + l * 64;
    const float2* rope = (const float2*)(ws + OFF_ROPE);
    bf16_t* dst = nt < 4 ? (bf16_t*)(ws + OFF_Q) : (bf16_t*)(ws + OFF_K);
    int ldd = nt < 4 ? 512 : 128;
    int cbase = (nt < 4 ? nt * 128 : 0) + wn * 64;
    f32x4 g[4];
#pragma unroll
    for (int ni = 0; ni < 4; ni++) g[ni] = *(const f32x4*)(gn + ni * 16 + q * 4);
#pragma unroll
    for (int mi = 0; mi < 4; mi++) {
      int m = m0 + wm * 64 + mi * 16 + r;
      float ss = 0.f;
#pragma unroll
      for (int ni = 0; ni < 4; ni++)
#pragma unroll
        for (int j = 0; j < 4; j++) ss += acc[ni][mi][j] * acc[ni][mi][j];
      ss += __shfl_xor(ss, 16); ss += __shfl_xor(ss, 32);
      float rs = rsqrtf(ss * (1.f / 64.f) + 1e-6f);
      int t = m & 2047;
      int prow = t >> 6, pcol = t & 63;
      f32x4 y[4];
#pragma unroll
      for (int ni = 0; ni < 4; ni++) y[ni] = acc[ni][mi] * rs * g[ni];
      f32x4 o[4];
#pragma unroll
      for (int j = 0; j < 4; j++) {
        float2 cr = rope[prow * 16 + q * 4 + j];
        float2 cc = rope[pcol * 16 + q * 4 + j];
        o[0][j] = y[0][j] * cr.x - y[1][j] * cr.y;
        o[1][j] = y[0][j] * cr.y + y[1][j] * cr.x;
        o[2][j] = y[2][j] * cc.x - y[3][j] * cc.y;
        o[3][j] = y[2][j] * cc.y + y[3][j] * cc.x;
      }
#pragma unroll
      for (int ni = 0; ni < 4; ni++)
        *(uint2*)(dst + (size_t)m * ldd + cbase + ni * 16 + q * 4) = make_uint2(pk2(o[ni][0], o[ni][1]), pk2(o[ni][2], o[ni][3]));
    }
  } else if (nt <= 17) {
    bf16_t* dst; int chbase, nch;
    if (nt == 5) { dst = (bf16_t*)(ws + OFF_VT); chbase = 0; nch = 128; }
    else { dst = (bf16_t*)(ws + OFF_HYT); chbase = (nt - 6) * 128; nch = 1536; }
    bf16_t* sT = (bf16_t*)smem;
    __syncthreads();
#pragma unroll
    for (int mi = 0; mi < 4; mi++) {
      int tl = wm * 64 + mi * 16 + r;
#pragma unroll
      for (int ni = 0; ni < 4; ni++)
#pragma unroll
        for (int j = 0; j < 4; j++) sT[(wn * 64 + ni * 16 + q * 4 + j) * 136 + tl] = (bf16_t)f2bf(acc[ni][mi][j]);
    }
    __syncthreads();
    {
      int b = m0 >> 11, t0 = m0 & 2047;
#pragma unroll
      for (int i = 0; i < 8; i++) {
        int id = tid + 256 * i;
        int ch = id >> 4, c16 = id & 15;
        uint4 v = *(const uint4*)(sT + ch * 136 + c16 * 8);
        *(uint4*)(dst + ((size_t)b * nch + chbase + ch) * SEQ + t0 + c16 * 8) = v;
      }
    }
  } else if (nt <= 29) {
    bf16_t* dst; int ldd, cbase;
    if (nt <= 19) { dst = (bf16_t*)(ws + OFF_GQ); ldd = 256; cbase = (nt - 18) * 128; }
    else if (nt <= 21) { dst = (bf16_t*)(ws + OFF_GK); ldd = 256; cbase = (nt - 20) * 128; }
    else if (nt <= 25) { dst = (bf16_t*)(ws + OFF_GV); ldd = 512; cbase = (nt - 22) * 128; }
    else { dst = (bf16_t*)(ws + OFF_GO); ldd = 512; cbase = (nt - 26) * 128; }
    cbase += wn * 64;
#pragma unroll
    for (int mi = 0; mi < 4; mi++) {
      int m = m0 + wm * 64 + mi * 16 + r;
#pragma unroll
      for (int ni = 0; ni < 4; ni++)
        *(uint2*)(dst + (size_t)m * ldd + cbase + ni * 16 + q * 4) =
            make_uint2(pk2(acc[ni][mi][0], acc[ni][mi][1]), pk2(acc[ni][mi][2], acc[ni][mi][3]));
    }
  } else {
    float* dst = (float*)(ws + OFF_GLR);
    if (wn == 0) {
#pragma unroll
      for (int mi = 0; mi < 4; mi++) {
        int m = m0 + wm * 64 + mi * 16 + r;
#pragma unroll
        for (int ni = 0; ni < 2; ni++) *(f32x4*)(dst + (size_t)m * 32 + ni * 16 + q * 4) = acc[ni][mi];
      }
    }
  }
}

NI void attn_unit(PRef P, int u, unsigned char* smem) {
  bf16_t* sK = (bf16_t*)smem;
  bf16_t* sVT = (bf16_t*)(smem + 9216);
  unsigned char* ws = P.ws;
  bf16_t* qb = (bf16_t*)(ws + OFF_Q);
  const bf16_t* kb = (const bf16_t*)(ws + OFF_K);
  const bf16_t* vt = (const bf16_t*)(ws + OFF_VT);
  int b = u >> 7, head = (u >> 4) & 7, qt = u & 15, kvh = head >> 2;
  int tid = opaque_tid(), lane = tid & 63, w = tid >> 6, ql = lane & 31, hh = lane >> 5;
  int tok = b * SEQ + qt * 128 + w * 32 + ql;
  bf16x8 qf[4];
#pragma unroll
  for (int ks = 0; ks < 4; ks++) qf[ks] = *(const bf16x8*)(qb + (size_t)tok * 512 + head * 64 + ks * 16 + hh * 8);
  f32x16 o[2];
#pragma unroll
  for (int i = 0; i < 16; i++) { o[0][i] = 0.f; o[1][i] = 0.f; }
  float mrun = -1e30f, lrun = 0.f;
  const float cs = 0.125f * 1.44269504088896f;
  uint4 pk[2], pv[2];
  int lrow = tid >> 3, lch = tid & 7;
  const bf16_t* kbase = kb + (size_t)(b * SEQ) * 128 + kvh * 64;
  const bf16_t* vbase = vt + (size_t)((b * 2 + kvh) * 64) * SEQ;
#pragma unroll
  for (int i = 0; i < 2; i++) {
    pk[i] = *(const uint4*)(kbase + (size_t)(lrow + 32 * i) * 128 + lch * 8);
    pv[i] = *(const uint4*)(vbase + (size_t)(lrow + 32 * i) * SEQ + lch * 8);
  }
  for (int kt = 0; kt < 32; kt++) {
    __syncthreads();
#pragma unroll
    for (int i = 0; i < 2; i++) {
      *(uint4*)(sK + (lrow + 32 * i) * 72 + lch * 8) = pk[i];
      *(uint2*)(sVT + (lrow + 32 * i) * 68 + lch * 8) = make_uint2(pv[i].x, pv[i].y);
      *(uint2*)(sVT + (lrow + 32 * i) * 68 + lch * 8 + 4) = make_uint2(pv[i].z, pv[i].w);
    }
    __syncthreads();
    if (kt + 1 < 32) {
#pragma unroll
      for (int i = 0; i < 2; i++) {
        pk[i] = *(const uint4*)(kbase + (size_t)((kt + 1) * 64 + lrow + 32 * i) * 128 + lch * 8);
        pv[i] = *(const uint4*)(vbase + (size_t)(lrow + 32 * i) * SEQ + (kt + 1) * 64 + lch * 8);
      }
    }
    f32x16 s[2];
#pragma unroll
    for (int i = 0; i < 16; i++) { s[0][i] = 0.f; s[1][i] = 0.f; }
#pragma unroll
    for (int mt2 = 0; mt2 < 2; mt2++)
#pragma unroll
      for (int ks = 0; ks < 4; ks++) {
        bf16x8 a = *(const bf16x8*)(sK + (mt2 * 32 + ql) * 72 + ks * 16 + hh * 8);
        s[mt2] = __builtin_amdgcn_mfma_f32_32x32x16_bf16(a, qf[ks], s[mt2], 0, 0, 0);
      }
    float mloc = s[0][0];
#pragma unroll
    for (int i = 0; i < 16; i++) { mloc = fmaxf(mloc, s[0][i]); mloc = fmaxf(mloc, s[1][i]); }
    mloc = fmaxf(mloc, __shfl_xor(mloc, 32));
    float mnew = fmaxf(mrun, mloc);
    bool grow = mnew > mrun;
    float alpha = __builtin_amdgcn_exp2f((mrun - mnew) * cs);
    mrun = mnew;
    float ls = 0.f;
    float mb = mnew * cs;
#pragma unroll
    for (int i = 0; i < 16; i++) {
      s[0][i] = __builtin_amdgcn_exp2f(s[0][i] * cs - mb); s[1][i] = __builtin_amdgcn_exp2f(s[1][i] * cs - mb);
      ls += s[0][i] + s[1][i];
    }
    lrun = lrun * alpha + ls;
    if (__any(grow)) {
#pragma unroll
      for (int i = 0; i < 16; i++) { o[0][i] *= alpha; o[1][i] *= alpha; }
    }
#pragma unroll
    for (int mt2 = 0; mt2 < 2; mt2++)
#pragma unroll
      for (int s2 = 0; s2 < 2; s2++) {
        union { bf16x8 v; unsigned u[4]; } pb;
#pragma unroll
        for (int j = 0; j < 4; j++) pb.u[j] = pk2(s[mt2][8 * s2 + 2 * j], s[mt2][8 * s2 + 2 * j + 1]);
#pragma unroll
        for (int dt = 0; dt < 2; dt++) {
          const bf16_t* vp = sVT + (dt * 32 + ql) * 68 + mt2 * 32 + s2 * 16 + hh * 4;
          union { bf16x8 v; uint2 u[2]; } av;
          av.u[0] = *(const uint2*)vp; av.u[1] = *(const uint2*)(vp + 8);
          o[dt] = __builtin_amdgcn_mfma_f32_32x32x16_bf16(av.v, pb.v, o[dt], 0, 0, 0);
        }
      }
  }
  float lt = lrun + __shfl_xor(lrun, 32);
  float inv = 1.f / lt;
#pragma unroll
  for (int dt = 0; dt < 2; dt++)
#pragma unroll
    for (int g = 0; g < 4; g++) {
      int d = dt * 32 + 8 * g + 4 * hh;
      *(uint2*)((bf16_t*)(ws + OFF_OA) + (size_t)tok * 512 + head * 64 + d) =
          make_uint2(pk2(o[dt][4 * g] * inv, o[dt][4 * g + 1] * inv), pk2(o[dt][4 * g + 2] * inv, o[dt][4 * g + 3] * inv));
    }
}

NI void memkv_tile(PRef P, int l, int mt, int nt, unsigned char* smem) {
  int tid = opaque_tid();
  bf16_t* sW = (bf16_t*)smem; bf16_t* sA = (bf16_t*)(smem + 18432);
  unsigned char* ws = P.ws;
  const float* rmem = (const float*)(ws + OFF_RMEM);
  int m0 = mt * 128;
  LdRowF32<128> la; la.tid = tid; la.p = P.in[1] + (size_t)m0 * 1024; la.ld = 1024; la.gain = nullptr;
  LdRowBf16<128> lw; lw.tid = tid; lw.p = (const bf16_t*)P.out + (size_t)l * WO_LAYER + (nt < 8 ? WO_WK : WO_WV) + (size_t)(nt & 7) * 128 * 1024; lw.ld = 1024;
  f32x4 acc[4][4]; zero_acc<4>(acc);
  gemm_kloop<4>(la, lw, 1024, acc, sW, sA);
  int lane = tid & 63, w = tid >> 6, r = lane & 15, q = lane >> 4, wn = w >> 1, wm = w & 1;
  bf16_t* mk = (bf16_t*)(ws + OFF_MEMK);
  bf16_t* mvt = (bf16_t*)(ws + OFF_MEMVT);
#pragma unroll
  for (int mi = 0; mi < 4; mi++) {
    int m = m0 + wm * 64 + mi * 16 + r;
    float rs = rmem[m];
#pragma unroll
    for (int ni = 0; ni < 4; ni++) {
      f32x4 v = acc[ni][mi] * rs;
      int n = (nt & 7) * 128 + wn * 64 + ni * 16 + q * 4;
      if (nt < 8) {
        *(uint2*)(mk + (size_t)m * 1024 + n) = make_uint2(pk2(v[0], v[1]), pk2(v[2], v[3]));
      } else {
        int b = m >> 8, key = m & 255;
#pragma unroll
        for (int j = 0; j < 4; j++) {
          int nn = n + j; int h = nn >> 8, d = nn & 255;
          mvt[(((size_t)b * 4 + h) * 256 + d) * 256 + key] = (bf16_t)f2bf(v[j]);
        }
      }
    }
  }
}

DI float logsigf(float x) { return fminf(x, 0.f) - log1pf(__expf(-fabsf(x))); }
DI void gla_gates(PRef P, int l, int h, int t0, int tid, const float* glrS, float* psum, float (&g)[32], float& off, float& total) {
  int d = tid & 63, dir = (tid >> 6) & 1, half = tid >> 7;
  const float* wl = P.in[15] + ((size_t)(l * 2 + dir) * 16) * 256 + h * 64 + d;
  float wr[16];
#pragma unroll
  for (int r = 0; r < 16; r++) wr[r] = wl[r * 256];
  float bias = P.in[16][(size_t)(l * 2 + dir) * 256 + h * 64 + d];
  float ps = 0.f;
#pragma unroll
  for (int j = 0; j < 32; j++) {
    int i = 32 * half + j;
    int c = dir ? 63 - i : i;
    const float* lr = glrS + c * 32 + dir * 16;
    float lg = bias;
#pragma unroll
    for (int r = 0; r < 16; r++) lg += lr[r] * wr[r];
    g[j] = logsigf(lg) * (1.f / 16.f);
    ps += g[j];
  }
  psum[(dir * 2 + half) * 64 + d] = ps;
  __syncthreads();
  float p0 = psum[(dir * 2) * 64 + d], p1 = psum[(dir * 2 + 1) * 64 + d];
  off = half ? p0 : 0.f;
  total = p0 + p1;
}
NI void gla_state_unit(PRef P, int l, int u, unsigned char* smem) {
  bf16_t* sVT = (bf16_t*)smem;
  bf16_t* sKK = (bf16_t*)(smem + 18432);
  float* glrS = (float*)(smem + 36864);
  float* psum = (float*)(smem + 45056);
  unsigned char* ws = P.ws;
  const bf16_t* gk = (const bf16_t*)(ws + OFF_GK);
  const bf16_t* gv = (const bf16_t*)(ws + OFF_GV);
  const float* glr = (const float*)(ws + OFF_GLR);
  float* decay = (float*)(ws + OFF_DECAY);
  bf16_t* gst = (bf16_t*)(ws + OFF_GST);
  int bh = u >> 5, m = u & 31, b = bh >> 2, h = bh & 3;
  int t0 = b * SEQ + m * 64;
  int tid = opaque_tid();
  __syncthreads();
#pragma unroll
  for (int i = 0; i < 8; i++) { int idx = tid + 256 * i; glrS[idx] = glr[(size_t)t0 * 32 + idx]; }
  {
    LdKMajBf16<128, false> lv; lv.tid = tid; lv.p = gv + (size_t)t0 * 512 + h * 128; lv.ld = 512;
    lv.load(0); lv.store(sVT);
  }
  __syncthreads();
  {
    float g[32], off, total;
    gla_gates(P, l, h, t0, tid, glrS, psum, g, off, total);
    int d = tid & 63, dir = (tid >> 6) & 1, half = tid >> 7;
    if (half == 0) decay[((size_t)u * 2 + dir) * 64 + d] = __expf(total);
    float val[32];
    float run = off;
#pragma unroll
    for (int j = 0; j < 32; j++) {
      int i = 32 * half + j;
      int c = dir ? 63 - i : i;
      run += g[j];
      float kv = bf2f(gk[(size_t)(t0 + c) * 256 + h * 64 + d]);
      val[j] = kv * __expf(total - run);
    }
    int cbase = dir ? 32 * (1 - half) : 32 * half;
#pragma unroll
    for (int mq = 0; mq < 4; mq++) {
      unsigned pw[4];
#pragma unroll
      for (int e = 0; e < 4; e++) {
        int jj = mq * 8 + e * 2;
        float a0 = dir ? val[31 - jj] : val[jj];
        float a1 = dir ? val[30 - jj] : val[jj + 1];
        pw[e] = pk2(a0, a1);
      }
      *(uint4*)(sKK + (dir * 64 + d) * 72 + cbase + mq * 8) = make_uint4(pw[0], pw[1], pw[2], pw[3]);
    }
  }
  __syncthreads();
  int lane = tid & 63, w = tid >> 6, r = lane & 15, q = lane >> 4;
  f32x4 acc[2][4][2];
#pragma unroll
  for (int a = 0; a < 2; a++)
#pragma unroll
    for (int bq = 0; bq < 4; bq++)
#pragma unroll
      for (int cq = 0; cq < 2; cq++) acc[a][bq][cq] = (f32x4){0.f, 0.f, 0.f, 0.f};
#pragma unroll
  for (int kk = 0; kk < 2; kk++) {
    bf16x8 bv[2];
#pragma unroll
    for (int et = 0; et < 2; et++) bv[et] = *(const bf16x8*)(sVT + (32 * w + et * 16 + r) * 72 + kk * 32 + q * 8);
#pragma unroll
    for (int dir = 0; dir < 2; dir++)
#pragma unroll
      for (int dt = 0; dt < 4; dt++) {
        bf16x8 a = *(const bf16x8*)(sKK + (dir * 64 + dt * 16 + r) * 72 + kk * 32 + q * 8);
#pragma unroll
        for (int et = 0; et < 2; et++) acc[dir][dt][et] = __builtin_amdgcn_mfma_f32_16x16x32_bf16(a, bv[et], acc[dir][dt][et], 0, 0, 0);
      }
  }
#pragma unroll
  for (int dir = 0; dir < 2; dir++)
#pragma unroll
    for (int dt = 0; dt < 4; dt++)
#pragma unroll
      for (int et = 0; et < 2; et++) {
        int e = 32 * w + et * 16 + r, d = dt * 16 + q * 4;
        f32x4 v = acc[dir][dt][et];
        *(uint2*)(gst + (((size_t)u * 2 + dir) * 128 + e) * 64 + d) = make_uint2(pk2(v[0], v[1]), pk2(v[2], v[3]));
      }
}

NI void gla_scan_unit(PRef P, int su, bool dry) {
  unsigned char* ws = P.ws;
  const float* decay = (const float*)(ws + OFF_DECAY);
  bf16_t* gst = (bf16_t*)(ws + OFF_GST);
  int id = su * 256 + opaque_tid();
  int d4 = id & 15, e = (id >> 4) & 127, dir = (id >> 11) & 1, bh = id >> 12;
  float S0 = 0.f, S1 = 0.f, S2 = 0.f, S3 = 0.f;
#pragma unroll 1
  for (int s0 = 0; s0 < 32; s0 += 8) {
    uint2 ds[8]; float4 dc[8];
#pragma unroll
    for (int i = 0; i < 8; i++) {
      int m = dir ? 31 - (s0 + i) : s0 + i;
      int u = bh * 32 + m;
      ds[i] = *(const uint2*)(gst + (((size_t)u * 2 + dir) * 128 + e) * 64 + d4 * 4);
      dc[i] = *(const float4*)(decay + ((size_t)u * 2 + dir) * 64 + d4 * 4);
    }
#pragma unroll
    for (int i = 0; i < 8; i++) {
      int m = dir ? 31 - (s0 + i) : s0 + i;
      int u = bh * 32 + m;
      bf16_t* ptr = gst + (((size_t)u * 2 + dir) * 128 + e) * 64 + d4 * 4;
      if (!dry) *(uint2*)ptr = make_uint2(pk2(S0, S1), pk2(S2, S3));
      S0 = dc[i].x * S0 + bflo(ds[i].x); S1 = dc[i].y * S1 + bfhi(ds[i].x);
      S2 = dc[i].z * S2 + bflo(ds[i].y); S3 = dc[i].w * S3 + bfhi(ds[i].y);
    }
  }
}

NI void gla_out_unit(PRef P, int l, int u, unsigned char* smem, bool dry) {
  bf16_t* sQ = (bf16_t*)smem;
  bf16_t* sK = (bf16_t*)(smem + 18432);
  bf16_t* sVT = (bf16_t*)(smem + 36864);
  float* glrS = (float*)(smem + 36864);
  float* psum = (float*)(smem + 36864 + 8192);
  float* red = (float*)(smem + 55296);
  unsigned char* ws = P.ws;
  const bf16_t* gq = (const bf16_t*)(ws + OFF_GQ);
  const bf16_t* gk = (const bf16_t*)(ws + OFF_GK);
  const bf16_t* gv = (const bf16_t*)(ws + OFF_GV);
  bf16_t* go = (bf16_t*)(ws + OFF_GO);
  const float* glr = (const float*)(ws + OFF_GLR);
  const bf16_t* gst = (const bf16_t*)(ws + OFF_GST);
  int bh = u >> 5, m = u & 31, b = bh >> 2, h = bh & 3;
  int t0 = b * SEQ + m * 64;
  int tid = opaque_tid();
  __syncthreads();
#pragma unroll
  for (int i = 0; i < 8; i++) { int idx = tid + 256 * i; glrS[idx] = glr[(size_t)t0 * 32 + idx]; }
  __syncthreads();
  {
    float g[32], off, total;
    gla_gates(P, l, h, t0, tid, glrS, psum, g, off, total);
    int d = tid & 63, dir = (tid >> 6) & 1, half = tid >> 7;
    float run = off;
#pragma unroll
    for (int j = 0; j < 32; j++) {
      int i = 32 * half + j;
      int c = dir ? 63 - i : i;
      run += g[j];
      float qv = bf2f(gq[(size_t)(t0 + c) * 256 + h * 64 + d]) * 0.125f;
      float kv = bf2f(gk[(size_t)(t0 + c) * 256 + h * 64 + d]);
      sQ[(dir * 64 + c) * 72 + d] = (bf16_t)f2bf(qv * __expf(run));
      sK[(dir * 64 + c) * 72 + d] = (bf16_t)f2bf(kv * __expf(-run));
    }
  }
  __syncthreads();
  {
    LdKMajBf16<128, false> lv; lv.tid = tid; lv.p = gv + (size_t)t0 * 512 + h * 128; lv.ld = 512;
    lv.load(0); lv.store(sVT);
  }
  __syncthreads();
  int lane = tid & 63, w = tid >> 6, r = lane & 15, q = lane >> 4;
  f32x4 o[2][4];
#pragma unroll
  for (int a = 0; a < 2; a++)
#pragma unroll
    for (int c = 0; c < 4; c++) o[a][c] = (f32x4){0.f, 0.f, 0.f, 0.f};
#pragma unroll
  for (int dir = 0; dir < 2; dir++) {
    f32x4 at[4][4];
#pragma unroll
    for (int a = 0; a < 4; a++)
#pragma unroll
      for (int c = 0; c < 4; c++) at[a][c] = (f32x4){0.f, 0.f, 0.f, 0.f};
#pragma unroll
    for (int kk = 0; kk < 2; kk++) {
      bf16x8 ka[4], qb[4];
#pragma unroll
      for (int st = 0; st < 4; st++) ka[st] = *(const bf16x8*)(sK + (dir * 64 + st * 16 + r) * 72 + kk * 32 + q * 8);
#pragma unroll
      for (int ct = 0; ct < 4; ct++) qb[ct] = *(const bf16x8*)(sQ + (dir * 64 + ct * 16 + r) * 72 + kk * 32 + q * 8);
#pragma unroll
      for (int st = 0; st < 4; st++)
#pragma unroll
        for (int ct = 0; ct < 4; ct++) at[st][ct] = __builtin_amdgcn_mfma_f32_16x16x32_bf16(ka[st], qb[ct], at[st][ct], 0, 0, 0);
    }
#pragma unroll
    for (int i = 0; i < 2; i++) {
      bf16x8 av[2];
#pragma unroll
      for (int et = 0; et < 2; et++) {
        const bf16_t* vp = sVT + (32 * w + et * 16 + r) * 72 + 32 * i + 4 * q;
        union { bf16x8 v; uint2 u2[2]; } t; t.u2[0] = *(const uint2*)vp; t.u2[1] = *(const uint2*)(vp + 16);
        av[et] = t.v;
      }
#pragma unroll
      for (int ct = 0; ct < 4; ct++) {
        int c = 16 * ct + r;
        float pv[8];
#pragma unroll
        for (int hf = 0; hf < 2; hf++)
#pragma unroll
          for (int j = 0; j < 4; j++) {
            int s = 16 * (2 * i + hf) + 4 * q + j;
            bool keep = dir == 0 ? (s <= c) : (s > c);
            pv[hf * 4 + j] = keep ? at[2 * i + hf][ct][j] : 0.f;
          }
        union { bf16x8 v; unsigned u4[4]; } pb;
#pragma unroll
        for (int j = 0; j < 4; j++) pb.u4[j] = pk2(pv[2 * j], pv[2 * j + 1]);
#pragma unroll
        for (int et = 0; et < 2; et++) o[et][ct] = __builtin_amdgcn_mfma_f32_16x16x32_bf16(av[et], pb.v, o[et][ct], 0, 0, 0);
      }
    }
#pragma unroll
    for (int kk = 0; kk < 2; kk++) {
      bf16x8 sa[2];
#pragma unroll
      for (int et = 0; et < 2; et++)
        sa[et] = *(const bf16x8*)(gst + (((size_t)u * 2 + dir) * 128 + 32 * w + et * 16 + r) * 64 + kk * 32 + q * 8);
#pragma unroll
      for (int ct = 0; ct < 4; ct++) {
        bf16x8 qb = *(const bf16x8*)(sQ + (dir * 64 + ct * 16 + r) * 72 + kk * 32 + q * 8);
#pragma unroll
        for (int et = 0; et < 2; et++) o[et][ct] = __builtin_amdgcn_mfma_f32_16x16x32_bf16(sa[et], qb, o[et][ct], 0, 0, 0);
      }
    }
  }
#pragma unroll
  for (int ct = 0; ct < 4; ct++) {
    float ss = 0.f;
#pragma unroll
    for (int et = 0; et < 2; et++)
#pragma unroll
      for (int j = 0; j < 4; j++) ss += o[et][ct][j] * o[et][ct][j];
    ss += __shfl_xor(ss, 16); ss += __shfl_xor(ss, 32);
    if (q == 0) red[w * 64 + ct * 16 + r] = ss;
  }
  __syncthreads();
  const float* onorm = P.in[17] + l * 128;
#pragma unroll
  for (int ct = 0; ct < 4; ct++) {
    int c = ct * 16 + r;
    float tot = red[c] + red[64 + c] + red[128 + c] + red[192 + c];
    float rs = rsqrtf(tot * (1.f / 128.f) + 1e-6f);
#pragma unroll
    for (int et = 0; et < 2; et++) {
      int e = 32 * w + et * 16 + 4 * q;
      f32x4 gn = *(const f32x4*)(onorm + e);
      bf16_t* gp = go + (size_t)(t0 + c) * 512 + h * 128 + e;
      uint2 gr = *(const uint2*)gp;
      float g0 = bflo(gr.x), g1 = bfhi(gr.x), g2 = bflo(gr.y), g3 = bfhi(gr.y);
      float y0 = o[et][ct][0] * rs * gn[0] * g0 * sigmoidf_(g0);
      float y1 = o[et][ct][1] * rs * gn[1] * g1 * sigmoidf_(g1);
      float y2 = o[et][ct][2] * rs * gn[2] * g2 * sigmoidf_(g2);
      float y3 = o[et][ct][3] * rs * gn[3] * g3 * sigmoidf_(g3);
      if (!dry) *(uint2*)gp = make_uint2(pk2(y0, y1), pk2(y2, y3));
    }
  }
}

NI void merge_tile(PRef P, int l, const float* hsrc, int mt, int nt, unsigned char* smem) {
  int tid = opaque_tid();
  bf16_t* sW = (bf16_t*)smem; bf16_t* sA = (bf16_t*)(smem + 18432);
  uint4* gslot = (uint4*)(smem + 36864) + tid * 4;
  unsigned char* ws = P.ws;
  const float* partial = (const float*)(ws + OFF_PART);
  int m0 = mt * 128, n0 = nt * 128;
  int lane = tid & 63, w = tid >> 6, r = lane & 15, q = lane >> 4, wn = w >> 1, wm = w & 1;
  f32x4 mix[4][4]; zero_acc<4>(mix);
#pragma unroll 1
  for (int br = 0; br < 3; br++) {
    f32x4 acc[4][4]; zero_acc<4>(acc);
    {
      int tid = opaque_tid();
      LdRowBf16<128> la; la.tid = tid; la.p = (const bf16_t*)(ws + OFF_HB) + (size_t)m0 * 1024; la.ld = 1024;
      LdRowBf16<128> lw; lw.tid = tid; lw.p = (const bf16_t*)(ws + OFF_WB) + (size_t)l * WS_WIN + (size_t)(3872 + br * 1024 + n0) * 1024; lw.ld = 1024;
      gemm_kloop<4>(la, lw, 1024, acc, sW, sA);
    }
#pragma unroll
    for (int mi = 0; mi < 4; mi++) {
      float rs = row_rstd(partial, m0 + wm * 64 + mi * 16 + r);
      unsigned pw[4];
#pragma unroll
      for (int ni = 0; ni < 4; ni++) {
        f32x4 v = acc[ni][mi] * rs;
        unsigned b0 = (unsigned)(sigmoidf_(v[0]) * 255.f + 0.5f), b1 = (unsigned)(sigmoidf_(v[1]) * 255.f + 0.5f);
        unsigned b2 = (unsigned)(sigmoidf_(v[2]) * 255.f + 0.5f), b3 = (unsigned)(sigmoidf_(v[3]) * 255.f + 0.5f);
        pw[ni] = b0 | (b1 << 8) | (b2 << 16) | (b3 << 24);
      }
      gslot[mi] = make_uint4(pw[0], pw[1], pw[2], pw[3]);
    }
    zero_acc<4>(acc);
    {
      int tid = opaque_tid();
      LdRowBf16<128> lw; lw.tid = tid; lw.p = (const bf16_t*)P.out + (size_t)l * WO_LAYER + WO_BR + (size_t)br * 524288 + (size_t)n0 * 512; lw.ld = 512;
      if (br == 1) {
        int b = m0 >> 11, t = m0 & 2047;
        LdKMajBf16<128> la; la.tid = tid; la.p = (const bf16_t*)(ws + OFF_HYT) + (size_t)b * 1536 * SEQ + t; la.ld = SEQ;
        gemm_kloop<4>(la, lw, 512, acc, sW, sA);
      } else {
        LdRowBf16<128> la; la.tid = tid; la.p = (const bf16_t*)(ws + (br == 0 ? OFF_OA : OFF_GO)) + (size_t)m0 * 512; la.ld = 512;
        gemm_kloop<4>(la, lw, 512, acc, sW, sA);
      }
    }
#pragma unroll
    for (int mi = 0; mi < 4; mi++) {
      uint4 gw = gslot[mi];
      unsigned pw[4] = {gw.x, gw.y, gw.z, gw.w};
#pragma unroll
      for (int ni = 0; ni < 4; ni++) {
        const float sc = 1.f / 255.f;
        mix[ni][mi][0] += (float)(pw[ni] & 255u) * sc * acc[ni][mi][0];
        mix[ni][mi][1] += (float)((pw[ni] >> 8) & 255u) * sc * acc[ni][mi][1];
        mix[ni][mi][2] += (float)((pw[ni] >> 16) & 255u) * sc * acc[ni][mi][2];
        mix[ni][mi][3] += (float)(pw[ni] >> 24) * sc * acc[ni][mi][3];
      }
    }
  }
  bf16_t* dst = (bf16_t*)(ws + OFF_MIXED);
#pragma unroll
  for (int mi = 0; mi < 4; mi++) {
    int m = m0 + wm * 64 + mi * 16 + r;
#pragma unroll
    for (int ni = 0; ni < 4; ni++)
      *(uint2*)(dst + (size_t)m * 1024 + n0 + wn * 64 + ni * 16 + q * 4) =
          make_uint2(pk2(mix[ni][mi][0], mix[ni][mi][1]), pk2(mix[ni][mi][2], mix[ni][mi][3]));
  }
}

template <bool WBF> NI void resid_tile(PRef P, const bf16_t* A, int lda, int K, const float* W, const bf16_t* Wt, bool final_out, int mt, int nt, unsigned char* smem, bool dry) {
  int tid = opaque_tid();
  bf16_t* sW = (bf16_t*)smem; bf16_t* sA = (bf16_t*)(smem + 18432);
  unsigned char* ws = P.ws;
  float* partial = (float*)(ws + OFF_PART);
  bf16_t* hb = (bf16_t*)(ws + OFF_HB);
  int m0 = mt * 128, n0 = nt * 128;
  LdRowBf16<128> la; la.tid = tid; la.p = A + (size_t)m0 * lda; la.ld = lda;
  f32x4 acc[4][4]; zero_acc<4>(acc);
  if constexpr (WBF) {
    LdRowBf16<128> lw; lw.tid = tid; lw.p = Wt + (size_t)n0 * K; lw.ld = K;
    gemm_kloop<4>(la, lw, K, acc, sW, sA);
  } else {
    LdKMajF32<128> lw; lw.tid = tid; lw.p = W + n0; lw.ld = 1024;
    gemm_kloop<4>(la, lw, K, acc, sW, sA);
  }
  int lane = tid & 63, w = tid >> 6, r = lane & 15, q = lane >> 4, wn = w >> 1, wm = w & 1;
#pragma unroll
  for (int mi = 0; mi < 4; mi++) {
    int m = m0 + wm * 64 + mi * 16 + r;
    float ss = 0.f;
#pragma unroll
    for (int ni = 0; ni < 4; ni++) {
      size_t off = (size_t)m * 1024 + n0 + wn * 64 + ni * 16 + q * 4;
      uint2 ho = *(const uint2*)(hb + off);
      f32x4 hv = acc[ni][mi];
      hv[0] += bflo(ho.x); hv[1] += bfhi(ho.x); hv[2] += bflo(ho.y); hv[3] += bfhi(ho.y);
      if (!dry) {
        if (final_out) *(f32x4*)(P.out + off) = hv;
        else *(uint2*)(hb + off) = make_uint2(pk2(hv[0], hv[1]), pk2(hv[2], hv[3]));
      }
      ss += hv[0] * hv[0] + hv[1] * hv[1] + hv[2] * hv[2] + hv[3] * hv[3];
    }
    ss += __shfl_xor(ss, 16); ss += __shfl_xor(ss, 32);
    if (q == 0 && !dry) partial[(size_t)m * 16 + nt * 2 + wn] = ss;
  }
}

NI void normed_tile(PRef P, const bf16_t* Wt, bf16_t* dst, int ldd, int mode, int mt, int nt, unsigned char* smem) {
  int tid = opaque_tid();
  bf16_t* sW = (bf16_t*)smem; bf16_t* sA = (bf16_t*)(smem + 18432);
  unsigned char* ws = P.ws;
  const float* partial = (const float*)(ws + OFF_PART);
  int m0 = mt * 128, n0 = nt * 128;
  LdRowBf16<128> la; la.tid = tid; la.p = (const bf16_t*)(ws + OFF_HB) + (size_t)m0 * 1024; la.ld = 1024;
  LdRowBf16<128> lw; lw.tid = tid; lw.p = Wt + (size_t)n0 * 1024; lw.ld = 1024;
  f32x4 acc[4][4]; zero_acc<4>(acc);
  gemm_kloop<4>(la, lw, 1024, acc, sW, sA);
  int lane = tid & 63, w = tid >> 6, r = lane & 15, q = lane >> 4, wn = w >> 1, wm = w & 1;
#pragma unroll
  for (int mi = 0; mi < 4; mi++) {
    int m = m0 + wm * 64 + mi * 16 + r;
    float rs = row_rstd(partial, m);
#pragma unroll
    for (int ni = 0; ni < 4; ni++) {
      f32x4 v = acc[ni][mi] * rs;
      if (mode == 1) {
#pragma unroll
        for (int j = 0; j < 4; j++) { float x = fmaxf(v[j], 0.f); v[j] = x * x; }
      }
      *(uint2*)(dst + (size_t)m * ldd + n0 + wn * 64 + ni * 16 + q * 4) = make_uint2(pk2(v[0], v[1]), pk2(v[2], v[3]));
    }
  }
}

NI void normed_tile256(PRef P, const bf16_t* Wt, bf16_t* dst, int ldd, int mode, int mt, int nt, unsigned char* smem) {
  int tid = opaque_tid();
  bf16_t* sW = (bf16_t*)smem; bf16_t* sA = (bf16_t*)(smem + 18432);
  unsigned char* ws = P.ws;
  const float* partial = (const float*)(ws + OFF_PART);
  int m0 = mt * 256, n0 = nt * 128;
  LdRowBf16<256> la; la.tid = tid; la.p = (const bf16_t*)(ws + OFF_HB) + (size_t)m0 * 1024; la.ld = 1024;
  LdRowBf16<128> lw; lw.tid = tid; lw.p = Wt + (size_t)n0 * 1024; lw.ld = 1024;
  f32x4 acc[4][8]; zero_acc<8>(acc);
  gemm_kloop<8>(la, lw, 1024, acc, sW, sA);
  int lane = tid & 63, w = tid >> 6, r = lane & 15, q = lane >> 4, wn = w >> 1, wm = w & 1;
#pragma unroll
  for (int mi = 0; mi < 8; mi++) {
    int m = m0 + wm * 128 + mi * 16 + r;
    float rs = row_rstd(partial, m);
#pragma unroll
    for (int ni = 0; ni < 4; ni++) {
      f32x4 v = acc[ni][mi] * rs;
      if (mode == 1) {
#pragma unroll
        for (int j = 0; j < 4; j++) { float x = fmaxf(v[j], 0.f); v[j] = x * x; }
      }
      *(uint2*)(dst + (size_t)m * ldd + n0 + wn * 64 + ni * 16 + q * 4) = make_uint2(pk2(v[0], v[1]), pk2(v[2], v[3]));
    }
  }
}

NI void xattn_unit(PRef P, int l, int u, unsigned char* smem) {
  bf16_t* sK = (bf16_t*)smem;
  float* rkS = (float*)(smem + 36864);
  unsigned char* ws = P.ws;
  const bf16_t* xq = (const bf16_t*)(ws + OFF_XQ);
  const bf16_t* mk = (const bf16_t*)(ws + OFF_MEMK);
  const bf16_t* mvt = (const bf16_t*)(ws + OFF_MEMVT);
  bf16_t* xo = (bf16_t*)(ws + OFF_XO);
  const float* qn = P.in[28] + l * 256;
  const float* kn = P.in[29] + l * 256;
  int bh = u >> 5, qt = u & 31, b = bh >> 2, h = bh & 3;
  int tid = opaque_tid(), lane = tid & 63, w = tid >> 6, r = lane & 15, q = lane >> 4;
  int tok = b * SEQ + qt * 64 + w * 16 + r;
  __syncthreads();
  {
    const uint4* kr = (const uint4*)(mk + (size_t)(b * 256 + tid) * 1024 + h * 256);
    float ss = 0.f;
#pragma unroll 8
    for (int i = 0; i < 32; i++) {
      uint4 v = kr[i];
      ss += bflo(v.x) * bflo(v.x) + bfhi(v.x) * bfhi(v.x) + bflo(v.y) * bflo(v.y) + bfhi(v.y) * bfhi(v.y)
          + bflo(v.z) * bflo(v.z) + bfhi(v.z) * bfhi(v.z) + bflo(v.w) * bflo(v.w) + bfhi(v.w) * bfhi(v.w);
    }
    rkS[tid] = rsqrtf(ss * (1.f / 256.f) + 1e-6f);
  }
  f32x4 s[16];
#pragma unroll
  for (int a = 0; a < 16; a++) s[a] = (f32x4){0.f, 0.f, 0.f, 0.f};
  float qss = 0.f;
  int lrow = tid >> 3, lch = tid & 7;
#pragma unroll 1
  for (int dc = 0; dc < 4; dc++) {
    __syncthreads();
    {
      f32x4 ga = *(const f32x4*)(qn + dc * 64 + lch * 8), gb = *(const f32x4*)(qn + dc * 64 + lch * 8 + 4);
      f32x4 ka = *(const f32x4*)(kn + dc * 64 + lch * 8), kb2 = *(const f32x4*)(kn + dc * 64 + lch * 8 + 4);
      ga *= ka; gb *= kb2;
#pragma unroll
      for (int i = 0; i < 8; i++) {
        int row = lrow + 32 * i;
        uint4 v = *(const uint4*)(mk + (size_t)(b * 256 + row) * 1024 + h * 256 + dc * 64 + lch * 8);
        uint4 o;
        o.x = pk2(bflo(v.x) * ga[0], bfhi(v.x) * ga[1]); o.y = pk2(bflo(v.y) * ga[2], bfhi(v.y) * ga[3]);
        o.z = pk2(bflo(v.z) * gb[0], bfhi(v.z) * gb[1]); o.w = pk2(bflo(v.w) * gb[2], bfhi(v.w) * gb[3]);
        *(uint4*)(sK + row * 72 + lch * 8) = o;
      }
    }
    __syncthreads();
#pragma unroll
    for (int ks = 0; ks < 2; ks++) {
      union { bf16x8 v; uint4 u4; } qf;
      qf.u4 = *(const uint4*)(xq + (size_t)tok * 1024 + h * 256 + dc * 64 + ks * 32 + q * 8);
      qss += bflo(qf.u4.x) * bflo(qf.u4.x) + bfhi(qf.u4.x) * bfhi(qf.u4.x) + bflo(qf.u4.y) * bflo(qf.u4.y) + bfhi(qf.u4.y) * bfhi(qf.u4.y)
           + bflo(qf.u4.z) * bflo(qf.u4.z) + bfhi(qf.u4.z) * bfhi(qf.u4.z) + bflo(qf.u4.w) * bflo(qf.u4.w) + bfhi(qf.u4.w) * bfhi(qf.u4.w);
#pragma unroll
      for (int kt = 0; kt < 16; kt++) {
        bf16x8 a = *(const bf16x8*)(sK + (kt * 16 + r) * 72 + ks * 32 + q * 8);
        s[kt] = __builtin_amdgcn_mfma_f32_16x16x32_bf16(a, qf.v, s[kt], 0, 0, 0);
      }
    }
  }
  qss += __shfl_xor(qss, 16); qss += __shfl_xor(qss, 32);
  float rq = rsqrtf(qss * (1.f / 256.f) + 1e-6f) * (1.f / 16.f);
  float mx = -1e30f;
#pragma unroll
  for (int kt = 0; kt < 16; kt++) {
    f32x4 rk4 = *(const f32x4*)(rkS + kt * 16 + q * 4);
    s[kt] = s[kt] * rq * rk4;
    mx = fmaxf(mx, fmaxf(fmaxf(s[kt][0], s[kt][1]), fmaxf(s[kt][2], s[kt][3])));
  }
  mx = fmaxf(mx, __shfl_xor(mx, 16)); mx = fmaxf(mx, __shfl_xor(mx, 32));
  float lsum = 0.f;
  bf16x8 pb[8];
#pragma unroll
  for (int i = 0; i < 8; i++) {
    union { bf16x8 v; unsigned u4[4]; } t;
#pragma unroll
    for (int hf = 0; hf < 2; hf++) {
      float p0 = __expf(s[2 * i + hf][0] - mx), p1 = __expf(s[2 * i + hf][1] - mx);
      float p2 = __expf(s[2 * i + hf][2] - mx), p3 = __expf(s[2 * i + hf][3] - mx);
      lsum += (p0 + p1) + (p2 + p3);
      t.u4[hf * 2] = pk2(p0, p1); t.u4[hf * 2 + 1] = pk2(p2, p3);
    }
    pb[i] = t.v;
  }
  lsum += __shfl_xor(lsum, 16); lsum += __shfl_xor(lsum, 32);
  float inv = 1.f / lsum;
#pragma unroll 1
  for (int dc = 0; dc < 4; dc++) {
    __syncthreads();
    {
      int row0 = tid >> 5, ch = tid & 31;
#pragma unroll
      for (int i = 0; i < 8; i++) {
        int row = row0 + 8 * i;
        uint4 v = *(const uint4*)(mvt + (((size_t)b * 4 + h) * 256 + dc * 64 + row) * 256 + ch * 8);
        *(uint4*)(sK + row * 264 + ch * 8) = v;
      }
    }
    __syncthreads();
    f32x4 o[4];
#pragma unroll
    for (int dt = 0; dt < 4; dt++) o[dt] = (f32x4){0.f, 0.f, 0.f, 0.f};
#pragma unroll
    for (int i = 0; i < 8; i++)
#pragma unroll
      for (int dt = 0; dt < 4; dt++) {
        const bf16_t* vp = sK + (dt * 16 + r) * 264 + 32 * i + 4 * q;
        union { bf16x8 v; uint2 u2[2]; } av;
        av.u2[0] = *(const uint2*)vp; av.u2[1] = *(const uint2*)(vp + 16);
        o[dt] = __builtin_amdgcn_mfma_f32_16x16x32_bf16(av.v, pb[i], o[dt], 0, 0, 0);
      }
#pragma unroll
    for (int dt = 0; dt < 4; dt++) {
      int d = dc * 64 + dt * 16 + q * 4;
      *(uint2*)(xo + (size_t)tok * 1024 + h * 256 + d) =
          make_uint2(pk2(o[dt][0] * inv, o[dt][1] * inv), pk2(o[dt][2] * inv, o[dt][3] * inv));
    }
  }
}


DI bool xcd_tile(int n, int bid, int G, int MT, int NT, int& mt, int& nt) {
  int NTG = (NT + 7) >> 3, MTG = (MT + 7) >> 3;
  int slots = G >> 3;
  int slot = bid >> 3, xcd = bid & 7;
  int per = (64 + slots - 1) / slots;
  int gi = n / per, sub = n % per;
  int g = gi * 8 + xcd;
  if (g >= NTG * MTG) return false;
  int s = slot + sub * slots;
  mt = -1; nt = 0;
  if (s < 64) {
    int mtg = g / NTG, ntg = g % NTG;
    int m_ = mtg * 8 + (s >> 3), n_ = ntg * 8 + (s & 7);
    if (m_ < MT && n_ < NT) { mt = m_; nt = n_; }
  }
  return true;
}

#define XB_TMO      128
#define XB_XCNT(j)  (256  + 64 * (j))
#define XB_XSUB(j)  (1280 + 64 * (j))
#define XB_XGEN(j)  (2304 + 64 * (j))
#define XB_TOP      3328
#define XB_TOPGEN   3392
#define XCD_BAR_WORDS 3456
#define XB_SPIN_CAP (1u << 18)
#define LAS __attribute__((address_space(3)))

__device__ __forceinline__ unsigned xb_ld(unsigned* p)              { return __hip_atomic_load(p, __ATOMIC_RELAXED, __HIP_MEMORY_SCOPE_AGENT); }
__device__ __forceinline__ unsigned xb_add(unsigned* p, unsigned v) { return __hip_atomic_fetch_add(p, v, __ATOMIC_RELAXED, __HIP_MEMORY_SCOPE_AGENT); }
__device__ __forceinline__ unsigned xb_xcc_id() { return (unsigned)__builtin_amdgcn_s_getreg((3 << 11) | 20) & 0xFu; }
#define XB_SPIN(cond, bar) do { unsigned _sp = 0; while (cond) { __builtin_amdgcn_s_sleep(1); \
    if ((++_sp & 255u) == 0u) { if (xb_ld(&(bar)[XB_TMO])) break; if (_sp > XB_SPIN_CAP) { atomicAdd(&(bar)[XB_TMO], 1u); break; } } } } while (0)

struct XcdBarrier {
    unsigned* bar; unsigned x;
    volatile LAS unsigned* st;
};

__device__ __forceinline__ XcdBarrier xcd_barrier_post(unsigned* bar, volatile LAS unsigned* st) {
    XcdBarrier b; b.bar = bar; b.x = xb_xcc_id(); b.st = st;
    if (threadIdx.x == 0) (void)xb_add(&bar[XB_XCNT(b.x)], 1u);
    return b;
}
__device__ __forceinline__ void xcd_barrier_complete(unsigned* bar, unsigned x, unsigned& nloc, unsigned& nx) {
    const unsigned G = gridDim.x * gridDim.y * gridDim.z;
    unsigned sum, cnt, mine, sp = 0u;
    for (;;) {
        sum = 0u; cnt = 0u; mine = 0u;
#pragma unroll
        for (unsigned j = 0; j < 16; ++j) { const unsigned c = xb_ld(&bar[XB_XCNT(j)]); sum += c; cnt += (c > 0u) ? 1u : 0u; mine = (j == x) ? c : mine; }
        if (sum == G) break;
        __builtin_amdgcn_s_sleep(1);
        if ((++sp & 255u) == 0u) { if (xb_ld(&bar[XB_TMO])) break; if (sp > XB_SPIN_CAP) { atomicAdd(&bar[XB_TMO], 1u); break; } }
    }
    nloc = mine > 0u ? mine : 1u; nx = cnt > 0u ? cnt : 1u;
}

__device__ __forceinline__ void xcd_barrier(const XcdBarrier& b) {
    asm volatile("s_waitcnt vmcnt(0)" ::: "memory");
    __syncthreads();
    if (threadIdx.x == 0) {
        unsigned* bar = b.bar;
        __builtin_amdgcn_s_waitcnt(0);
        unsigned nloc = b.st[0], nx = b.st[1];
        if (nloc == 0u) { xcd_barrier_complete(bar, b.x, nloc, nx); b.st[0] = nloc; b.st[1] = nx; }
        const unsigned old = xb_add(&bar[XB_XSUB(b.x)], 1u);
        const unsigned gen = old / nloc;
        if (old + 1u == (gen + 1u) * nloc) {
            __builtin_amdgcn_fence(__ATOMIC_RELEASE, "agent");
            asm volatile("s_waitcnt vmcnt(0)" ::: "memory");
            const unsigned og = xb_add(&bar[XB_TOP], 1u);
            const unsigned tg = og / nx;
            if (og + 1u == (tg + 1u) * nx) xb_add(&bar[XB_TOPGEN], 1u);
            else XB_SPIN(xb_ld(&bar[XB_TOPGEN]) == tg, bar);
            __builtin_amdgcn_fence(__ATOMIC_ACQUIRE, "");
            xb_add(&bar[XB_XGEN(b.x)], 1u);
            asm volatile("s_waitcnt vmcnt(0)" ::: "memory");
        } else {
            XB_SPIN(xb_ld(&bar[XB_XGEN(b.x)]) == gen, bar);
            __builtin_amdgcn_fence(__ATOMIC_ACQUIRE, "");
            asm volatile("s_waitcnt vmcnt(0)" ::: "memory");
        }
    }
    __syncthreads();
}


#define OPQ(x) ({ int _t = (x); asm volatile("" : "+s"(_t)); _t; })
#ifndef DUP_P1
#define DUP_P1 0
#endif
#ifndef DUP_P2a
#define DUP_P2a 0
#endif
#ifndef DUP_P2b
#define DUP_P2b 0
#endif
#ifndef DUP_P2c
#define DUP_P2c 0
#endif
#ifndef DUP_P4
#define DUP_P4 0
#endif
#ifndef DUP_P5
#define DUP_P5 0
#endif
#ifndef DUP_P6
#define DUP_P6 0
#endif
#ifndef DUP_P7
#define DUP_P7 0
#endif
#ifndef DUP_P8
#define DUP_P8 0
#endif
#ifndef DUP_P9
#define DUP_P9 0
#endif
#ifndef DUP_P10
#define DUP_P10 0
#endif
__global__ void __launch_bounds__(256, 2) fwd_megakernel(Params Parg) {
  __shared__ __attribute__((aligned(16))) unsigned char smem[57344];
  cg::grid_group grid = cg::this_grid();
  const int G = gridDim.x, bid = blockIdx.x;
  PPtr Pk = (PPtr)__builtin_amdgcn_kernarg_segment_ptr();
#define P (*launder_p(Pk))
#define ws (P.ws)

  __shared__ uint4 xb_words;
  if (threadIdx.x == 0) xb_words = make_uint4(0u, 0u, 0u, 0u);
  __syncthreads();
  XcdBarrier xb = xcd_barrier_post((unsigned*)(ws + OFF_BAR), (volatile LAS unsigned*)&xb_words);
  for (int it = bid; it < 1760; it += G) wconv_job(P, it, smem);
  phase0(P, smem);
  for (int it = 1760 + bid; it < NWCONV; it += G) wconv_job(P, it, smem);
  xcd_barrier(xb);
  xcd_barrier(xb);
  const int probe_nd = *(volatile const int*)(ws + OFF_PROBE);
  if (probe_nd < 0) grid.sync();
#ifdef DUP_SYNC
  for (int i = 0; i < 20; i++) grid.sync();
#endif

#pragma unroll 1
  for (int l = 0; l < 2; l++) {
    const float* hsrc = l == 0 ? P.in[0] : P.out;
    const bf16_t* wbl = (const bf16_t*)P.out + (size_t)OPQ(l) * WO_LAYER;
    for (int rep = 0; rep < 1 + DUP_P1; rep++) {
      for (int it = bid; it < 512; it += G) hy_spectra_job(P, OPQ(l), it, smem);
      int mt, nt;
      for (int n = 0; xcd_tile(n, bid, G, 128, 31, mt, nt); n++) if (mt >= 0) inproj_tile(P, OPQ(l), hsrc, mt, nt, smem);
    }
    xcd_barrier(xb);
    for (int rep = 0; rep < 1 + DUP_P2a; rep++) for (int it = bid; it < 1024 + 1024 + 256; it += G) {
      if (it < 1024) attn_unit(P, it, smem);
      else if (it < 2048) gla_state_unit(P, OPQ(l), it - 1024, smem);
      else { int t = it - 2048; memkv_tile(P, OPQ(l), t >> 4, t & 15, smem); }
    }
    xcd_barrier(xb);
    for (int rep = 0; rep < 1 + DUP_P2b; rep++) for (int it = bid; it < 512 + 2048; it += G) {
      if (it < 512) gla_scan_unit(P, it, (rep < DUP_P2b * probe_nd));
      else { int t = it - 512; hy_conv_job(P, OPQ(l), t >> 2, t & 3, smem, (rep < DUP_P2b * probe_nd)); }
    }
    xcd_barrier(xb);
    for (int rep = 0; rep < 1 + DUP_P2c; rep++) for (int it = bid; it < 1024; it += G) gla_out_unit(P, OPQ(l), it, smem, (rep < DUP_P2c * probe_nd));
    xcd_barrier(xb);
    for (int rep = 0; rep < 1 + DUP_P4; rep++) { int mt, nt; for (int n = 0; xcd_tile(n, bid, G, 128, 8, mt, nt); n++) if (mt >= 0) merge_tile(P, OPQ(l), hsrc, mt, nt, smem); }
    xcd_barrier(xb);
    for (int rep = 0; rep < 1 + DUP_P5; rep++) { int mt, nt; for (int n = 0; xcd_tile(n, bid, G, 128, 8, mt, nt); n++) if (mt >= 0)
      resid_tile<true>(P, (const bf16_t*)(ws + OFF_MIXED), 1024, 1024, nullptr, wbl + WO_WOUT, false, mt, nt, smem, (rep < DUP_P5 * probe_nd)); }
    xcd_barrier(xb);
    for (int rep = 0; rep < 1 + DUP_P6; rep++) { int mt, nt; for (int n = 0; xcd_tile(n, bid, G, 128, 8, mt, nt); n++) if (mt >= 0)
      normed_tile(P, wbl + WO_WQ, (bf16_t*)(ws + OFF_XQ), 1024, 0, mt, nt, smem); }
    xcd_barrier(xb);
    for (int rep = 0; rep < 1 + DUP_P7; rep++) for (int it = bid; it < 1024; it += G) xattn_unit(P, OPQ(l), it, smem);
    xcd_barrier(xb);
    for (int rep = 0; rep < 1 + DUP_P8; rep++) { int mt, nt; for (int n = 0; xcd_tile(n, bid, G, 128, 8, mt, nt); n++) if (mt >= 0)
      resid_tile<true>(P, (const bf16_t*)(ws + OFF_XO), 1024, 1024, nullptr, wbl + WO_WO, false, mt, nt, smem, (rep < DUP_P8 * probe_nd)); }
    xcd_barrier(xb);
    for (int rep = 0; rep < 1 + DUP_P9; rep++) { int mt, nt; for (int n = 0; xcd_tile(n, bid, G, 64, 32, mt, nt); n++) if (mt >= 0)
      normed_tile256(P, wbl + WO_W1, (bf16_t*)(ws + OFF_HID), 4096, 1, mt, nt, smem); }
    xcd_barrier(xb);
    for (int rep = 0; rep < 1 + DUP_P10; rep++) { int mt, nt; for (int n = 0; xcd_tile(n, bid, G, 128, 8, mt, nt); n++) if (mt >= 0)
      resid_tile<true>(P, (const bf16_t*)(ws + OFF_HID), 4096, 4096, nullptr, (l == 0 ? wbl + WO_W2 : (const bf16_t*)(ws + OFF_WB) + WS_W2L1), l == 1, mt, nt, smem, (rep < DUP_P10 * probe_nd)); }
    xcd_barrier(xb);
  }
}
#undef P
#undef ws

extern "C" void kernel_launch(void* const* d_in, const int* in_sizes, int n_in, void* d_out, int out_size, void* d_ws,
                              size_t ws_size, hipStream_t stream) {
  static int grid_blocks = 0;
  if (!grid_blocks) {
    int dev = 0, cus = 0, per_cu = 0;
    hipGetDevice(&dev);
    hipDeviceGetAttribute(&cus, hipDeviceAttributeMultiprocessorCount, dev);
    hipOccupancyMaxActiveBlocksPerMultiprocessor(&per_cu, fwd_megakernel, 256, 0);
    if (per_cu > 2) per_cu = 2;
    if (per_cu < 1) per_cu = 1;
    grid_blocks = cus * per_cu;
  }
  Params p{};
  for (int i = 0; i < 33; i++) p.in[i] = (const float*)d_in[i];
  p.out = (float*)d_out;
  p.ws = (unsigned char*)d_ws;
  (void)hipMemsetAsync((unsigned char*)d_ws + OFF_BAR, 0, 16384, stream);
  void* args[] = {&p};
  hipError_t e = hipLaunchCooperativeKernel((void*)fwd_megakernel, dim3(grid_blocks), dim3(256), args, 0, stream);
  if (e != hipSuccess) fprintf(stderr, "cooperative launch failed: %s (grid %d)\n", hipGetErrorString(e), grid_blocks);
}
```

```cpp
#include <hip/hip_runtime.h>
#include <hip/hip_cooperative_groups.h>
#include <cstdio>
namespace cg = cooperative_groups;

typedef __attribute__((ext_vector_type(8))) short bf16x8;
typedef __attribute__((ext_vector_type(4))) float f32x4;
typedef __attribute__((ext_vector_type(16))) float f32x16;
typedef unsigned short bf16_t;

#define DI __device__ __forceinline__
#ifndef NI
#define NI __device__ __forceinline__
#endif

constexpr int NT = 256;
constexpr int SEQ = 2048;
constexpr int TOK = 16384;
constexpr int NIN = 6944;
constexpr size_t MiB = 1ull << 20;

constexpr size_t OFF_SPEC = 0;
constexpr size_t OFF_PART = 17 * MiB;
constexpr size_t OFF_DECAY = 18 * MiB;
constexpr size_t OFF_H2 = 18 * MiB + 512 * 1024;
constexpr size_t OFF_TW = 19 * MiB + 512 * 1024;
constexpr size_t OFF_ROPE = OFF_TW + 32 * 1024;
constexpr size_t OFF_RMEM = OFF_ROPE + 8 * 1024;
constexpr size_t OFF_PROBE = OFF_RMEM + 8 * 1024;
constexpr size_t OFF_MEMK = 20 * MiB;
constexpr size_t OFF_MEMVT = 24 * MiB;
constexpr size_t OFF_BAR = 28 * MiB;
constexpr size_t OFF_Q = 29 * MiB;
constexpr size_t OFF_OA = OFF_Q;
constexpr size_t OFF_K = 45 * MiB;
constexpr size_t OFF_VT = 49 * MiB;
constexpr size_t OFF_HYT = 53 * MiB;
constexpr size_t OFF_GQ = 101 * MiB;
constexpr size_t OFF_GK = 109 * MiB;
constexpr size_t OFF_GV = 117 * MiB;
constexpr size_t OFF_GO = 133 * MiB;
constexpr size_t OFF_GLR = 149 * MiB;
constexpr size_t OFF_GST = 151 * MiB;
constexpr size_t OFF_MIXED = 151 * MiB;
constexpr size_t OFF_HB = 183 * MiB;
constexpr size_t OFF_WB = 215 * MiB;
constexpr size_t OFF_XQ = 29 * MiB;
constexpr size_t OFF_XO = 61 * MiB;
constexpr size_t OFF_HID = 29 * MiB;
constexpr size_t WS_WIN = 7110656;
constexpr size_t WS_W2L1 = 2 * WS_WIN;
constexpr size_t WO_WOUT = 0;
constexpr size_t WO_WQ = 1048576;
constexpr size_t WO_W1 = 2097152;
constexpr size_t WO_W2 = 6291456;
constexpr size_t WO_WK = 10485760;
constexpr size_t WO_WV = WO_WK + 1048576;
constexpr size_t WO_WO = WO_WV + 1048576;
constexpr size_t WO_BR = WO_WO + 1048576;
constexpr size_t WO_LAYER = WO_BR + 1572864;
constexpr int NWL = 128 + 128 + 512 + 512 + 128 * 3 + 192;
constexpr int NWCONV = 2 * 880 + 2 * NWL;

struct Params {
  const float* in[33];
  float* out;
  unsigned char* ws;
};
typedef const __attribute__((address_space(4))) Params& PRef;
typedef const __attribute__((address_space(4))) Params* PPtr;
__device__ __forceinline__ PPtr launder_p(PPtr p) { asm volatile("" : "+s"(p)); return p; }

DI int opaque_tid() { int t = threadIdx.x; asm volatile("" : "+v"(t)); return t; }
typedef __bf16 bf2_t __attribute__((ext_vector_type(2)));
typedef float f2_t __attribute__((ext_vector_type(2)));
DI unsigned f2bf(float f) { __bf16 h = (__bf16)f; return (unsigned)__builtin_bit_cast(unsigned short, h); }
DI float bf2f(unsigned h) { return __uint_as_float(h << 16); }
DI unsigned pk2(float a, float b) { f2_t v = {a, b}; return __builtin_bit_cast(unsigned, __builtin_convertvector(v, bf2_t)); }
DI float bflo(unsigned u) { return __uint_as_float(u << 16); }
DI float bfhi(unsigned u) { return __uint_as_float(u & 0xffff0000u); }
DI float sigmoidf_(float x) { return 1.f / (1.f + __expf(-x)); }

DI float row_rstd(const float* partial, int m) {
  const float4* p = (const float4*)(partial + (size_t)m * 16);
  float4 a = p[0], b = p[1], c = p[2], d = p[3];
  float s = a.x + a.y + a.z + a.w + b.x + b.y + b.z + b.w + c.x + c.y + c.z + c.w + d.x + d.y + d.z + d.w;
  return rsqrtf(s * (1.f / 1024.f) + 1e-6f);
}

DI int swz_off(int row, int k) {
  int st = (row >> 4) * 2 + (k >> 5);
  int ob = (row & 15) * 64 + (k & 31) * 2;
  return (st * 1024 + (ob ^ (((ob >> 9) & 1) << 5))) >> 1;
}
DI int lds_off(bool swz, int row, int k) { return swz ? swz_off(row, k) : row * 72 + k; }

template <int ROWS, bool SWZ = true> struct LdRowF32 {
  static constexpr int NV = ROWS / 16;
  const float* p; int ld; const float* gain; int tid; f32x4 r[NV];
  DI void load(int k0) {
    int c4 = tid & 15, r0 = tid >> 4;
    f32x4 g = (f32x4){1.f, 1.f, 1.f, 1.f};
    if (gain) g = *(const f32x4*)(gain + k0 + c4 * 4);
#pragma unroll
    for (int i = 0; i < NV; i++) {
      f32x4 v = *(const f32x4*)(p + (unsigned)((r0 + 16 * i) * ld + k0 + c4 * 4));
      r[i] = v * g;
    }
  }
  DI void store(bf16_t* s) {
    int c4 = tid & 15, r0 = tid >> 4;
#pragma unroll
    for (int i = 0; i < NV; i++)
      *(uint2*)(s + lds_off(SWZ, r0 + 16 * i, c4 * 4)) = make_uint2(pk2(r[i][0], r[i][1]), pk2(r[i][2], r[i][3]));
  }
};

template <int ROWS, bool SWZ = true> struct LdRowBf16 {
  static constexpr int NV = ROWS / 32;
  const bf16_t* p; int ld; int tid; uint4 r[NV];
  DI void load(int k0) {
    int ch = tid & 7, r0 = tid >> 3;
#pragma unroll
    for (int i = 0; i < NV; i++) r[i] = *(const uint4*)(p + (unsigned)((r0 + 32 * i) * ld + k0 + ch * 8));
  }
  DI void store(bf16_t* s) {
    int ch = tid & 7, r0 = tid >> 3;
#pragma unroll
    for (int i = 0; i < NV; i++) *(uint4*)(s + lds_off(SWZ, r0 + 32 * i, ch * 8)) = r[i];
  }
};

template <int COLS, bool SWZ = true> struct LdKMajF32 {
  static constexpr int KPT = COLS / 16;
  static constexpr int KG = 64 / KPT;
  const float* p; int ld; int tid; const float* gain = nullptr; int ncol = COLS; f32x4 r[KPT];
  DI void load(int k0) {
    int kg = tid % KG, ng = tid / KG;
    int c0 = ng * 4 < ncol ? ng * 4 : 0;
#pragma unroll
    for (int i = 0; i < KPT; i++) {
      f32x4 v = *(const f32x4*)(p + (unsigned)((k0 + kg * KPT + i) * ld + c0));
      if (gain) v *= gain[k0 + kg * KPT + i];
      r[i] = v;
    }
  }
  DI void store(bf16_t* s) {
    int kg = tid % KG, ng = tid / KG;
#pragma unroll
    for (int c = 0; c < 4; c++) {
      if constexpr (KPT == 8) {
        uint4 v = make_uint4(pk2(r[0][c], r[1][c]), pk2(r[2][c], r[3][c]), pk2(r[4][c], r[5][c]), pk2(r[6][c], r[7][c]));
        *(uint4*)(s + lds_off(SWZ, ng * 4 + c, kg * 8)) = v;
      } else {
        uint2 v = make_uint2(pk2(r[0][c], r[1][c]), pk2(r[2][c], r[3][c]));
        *(uint2*)(s + lds_off(SWZ, ng * 4 + c, kg * 4)) = v;
      }
    }
  }
};

DI unsigned getbf(uint2 v, int c) { return c == 0 ? (v.x & 0xffffu) : c == 1 ? (v.x >> 16) : c == 2 ? (v.y & 0xffffu) : (v.y >> 16); }

template <int COLS, bool SWZ = true> struct LdKMajBf16 {
  static constexpr int KPT = COLS / 16;
  static constexpr int KG = 64 / KPT;
  const bf16_t* p; int ld; int tid; uint2 r[KPT];
  DI void load(int k0) {
    int kg = tid % KG, ng = tid / KG;
#pragma unroll
    for (int i = 0; i < KPT; i++) r[i] = *(const uint2*)(p + (unsigned)((k0 + kg * KPT + i) * ld + ng * 4));
  }
  DI void store(bf16_t* s) {
    int kg = tid % KG, ng = tid / KG;
#pragma unroll
    for (int c = 0; c < 4; c++) {
      if constexpr (KPT == 8) {
        uint4 v = make_uint4(getbf(r[0], c) | (getbf(r[1], c) << 16), getbf(r[2], c) | (getbf(r[3], c) << 16),
                             getbf(r[4], c) | (getbf(r[5], c) << 16), getbf(r[6], c) | (getbf(r[7], c) << 16));
        *(uint4*)(s + lds_off(SWZ, ng * 4 + c, kg * 8)) = v;
      } else {
        uint2 v = make_uint2(getbf(r[0], c) | (getbf(r[1], c) << 16), getbf(r[2], c) | (getbf(r[3], c) << 16));
        *(uint2*)(s + lds_off(SWZ, ng * 4 + c, kg * 4)) = v;
      }
    }
  }
};

template <int MI> DI void mma_step(const bf16_t* sW, const bf16_t* sA, f32x4 (&acc)[4][MI], int tid) {
  int lane = tid & 63, w = tid >> 6, r = lane & 15, q = lane >> 4;
  int wn = w >> 1, wm = w & 1;
  int lane_off = ((r * 64 + q * 16) ^ ((r >> 3) << 5)) >> 1;
  const bf16_t* pw = sW + wn * 4 * 1024 + lane_off;
  const bf16_t* pa = sA + wm * MI * 1024 + lane_off;
#pragma unroll
  for (int kk = 0; kk < 2; kk++) {
    bf16x8 a[4], b[MI];
#pragma unroll
    for (int ni = 0; ni < 4; ni++) a[ni] = *(const bf16x8*)(pw + (ni * 2 + kk) * 512);
#pragma unroll
    for (int mi = 0; mi < MI; mi++) b[mi] = *(const bf16x8*)(pa + (mi * 2 + kk) * 512);
#pragma unroll
    for (int ni = 0; ni < 4; ni++)
#pragma unroll
      for (int mi = 0; mi < MI; mi++) acc[ni][mi] = __builtin_amdgcn_mfma_f32_16x16x32_bf16(a[ni], b[mi], acc[ni][mi], 0, 0, 0);
  }
}

template <int MI> DI void mma_step_plain(const bf16_t* sW, const bf16_t* sA, f32x4 (&acc)[4][MI], int tid) {
  int lane = tid & 63, w = tid >> 6, r = lane & 15, q = lane >> 4;
  int wn = w >> 1, wm = w & 1;
#pragma unroll
  for (int kk = 0; kk < 2; kk++) {
    bf16x8 a[4], b[MI];
#pragma unroll
    for (int ni = 0; ni < 4; ni++) a[ni] = *(const bf16x8*)(sW + (wn * 64 + ni * 16 + r) * 72 + kk * 32 + q * 8);
#pragma unroll
    for (int mi = 0; mi < MI; mi++) b[mi] = *(const bf16x8*)(sA + (wm * 16 * MI + mi * 16 + r) * 72 + kk * 32 + q * 8);
#pragma unroll
    for (int ni = 0; ni < 4; ni++)
#pragma unroll
      for (int mi = 0; mi < MI; mi++) acc[ni][mi] = __builtin_amdgcn_mfma_f32_16x16x32_bf16(a[ni], b[mi], acc[ni][mi], 0, 0, 0);
  }
}
template <int MI, class LA, class LW> DI void gemm_kloop_plain(LA& la, LW& lw, int K, f32x4 (&acc)[4][MI], bf16_t* sW, bf16_t* sA) {
  la.load(0); lw.load(0);
  for (int k0 = 0; k0 < K; k0 += 64) {
    __syncthreads();
    la.store(sA); lw.store(sW);
    __syncthreads();
    if (k0 + 64 < K) { la.load(k0 + 64); lw.load(k0 + 64); }
    mma_step_plain<MI>(sW, sA, acc, la.tid);
  }
}
template <int MI, class LA, class LW> DI void gemm_kloop(LA& la, LW& lw, int K, f32x4 (&acc)[4][MI], bf16_t* sW, bf16_t* sA) {
  la.load(0); lw.load(0);
  for (int k0 = 0; k0 < K; k0 += 64) {
    __syncthreads();
    la.store(sA); lw.store(sW);
    __syncthreads();
    if (k0 + 64 < K) { la.load(k0 + 64); lw.load(k0 + 64); }
    mma_step<MI>(sW, sA, acc, la.tid);
  }
}

template <int MI, class LA, class LW> DI void gemm_kloop2(LA& la, LW& lw, int K, f32x4 (&acc)[4][MI], bf16_t* sW, bf16_t* sA) {
  LA la1 = la; LW lw1 = lw;
  la.load(0); lw.load(0);
  la1.load(64); lw1.load(64);
  for (int k0 = 0; k0 < K; k0 += 128) {
    __syncthreads();
    la.store(sA); lw.store(sW);
    __syncthreads();
    if (k0 + 128 < K) { la.load(k0 + 128); lw.load(k0 + 128); }
    mma_step<MI>(sW, sA, acc, la.tid);
    __syncthreads();
    la1.store(sA); lw1.store(sW);
    __syncthreads();
    if (k0 + 192 < K) { la1.load(k0 + 192); lw1.load(k0 + 192); }
    mma_step<MI>(sW, sA, acc, la.tid);
  }
}

template <int MI> DI void zero_acc(f32x4 (&acc)[4][MI]) {
#pragma unroll
  for (int a = 0; a < 4; a++)
#pragma unroll
    for (int b = 0; b < MI; b++) acc[a][b] = (f32x4){0.f, 0.f, 0.f, 0.f};
}

DI float2 cmul(float2 a, float2 b) { return make_float2(a.x * b.x - a.y * b.y, a.x * b.y + a.y * b.x); }
DI void fft_fill_twl(float2* twl, const float2* __restrict__ tw, int tid) {
#pragma unroll
  for (int i = 0; i < 4; i++) {
    int j = tid + 256 * i;
    float s, c; sincospif((float)j * (1.0f / 512.0f), &s, &c);
    twl[j] = make_float2(c, -s);
  }
  if (tid < 4) { float s, c; sincospif((float)tid * (1.0f / 2048.0f), &s, &c); twl[1024 + tid] = make_float2(c, -s); }
}
DI int bi(int x) { return x + (x >> 4); }
DI void dft4(float2 x0, float2 x1, float2 x2, float2 x3, float2& y0, float2& y1, float2& y2, float2& y3) {
  float2 v0 = make_float2(x0.x + x2.x, x0.y + x2.y), v1 = make_float2(x0.x - x2.x, x0.y - x2.y);
  float2 v2 = make_float2(x1.x + x3.x, x1.y + x3.y), dd = make_float2(x1.x - x3.x, x1.y - x3.y);
  float2 v3 = make_float2(dd.y, -dd.x);
  y0 = make_float2(v0.x + v2.x, v0.y + v2.y);
  y1 = make_float2(v1.x + v3.x, v1.y + v3.y);
  y2 = make_float2(v0.x - v2.x, v0.y - v2.y);
  y3 = make_float2(v1.x - v3.x, v1.y - v3.y);
}
DI void fft4096(float2* buf, const float2* __restrict__ tw, const float2* twl, int tid) {
#pragma unroll 1
  for (int lp = 0; lp < 12; lp += 4) {
    int p = 1 << lp;
    int sh = 8 - lp;
    int k = tid & (p - 1);
    int j = ((tid - k) << 4) + k;
    float2 u[16];
#pragma unroll
    for (int n = 0; n < 16; n++) u[n] = buf[bi(tid + 256 * n)];
    if (lp == 4) {
#pragma unroll
      for (int n = 1; n < 16; n++) { int m = (k * n) << sh; u[n] = cmul(u[n], twl[m >> 2]); }
    } else if (lp == 8) {
#pragma unroll
      for (int n = 1; n < 16; n++) { int m = k * n; u[n] = cmul(u[n], cmul(twl[m >> 2], twl[1024 + (m & 3)])); }
    }
    const float c1 = 0.92387953251128674f, s1 = 0.38268343236508977f, h = 0.70710678118654752f;
#pragma unroll
    for (int bq = 0; bq < 4; bq++) {
      float2 r0, r1, r2, r3;
      dft4(u[bq], u[4 + bq], u[8 + bq], u[12 + bq], r0, r1, r2, r3);
      if (bq == 1) { r1 = cmul(r1, make_float2(c1, -s1)); r2 = cmul(r2, make_float2(h, -h)); r3 = cmul(r3, make_float2(s1, -c1)); }
      if (bq == 2) { r1 = cmul(r1, make_float2(h, -h)); r2 = make_float2(r2.y, -r2.x); r3 = cmul(r3, make_float2(-h, -h)); }
      if (bq == 3) { r1 = cmul(r1, make_float2(s1, -c1)); r2 = cmul(r2, make_float2(-h, -h)); r3 = cmul(r3, make_float2(-c1, s1)); }
      u[bq] = r0; u[4 + bq] = r1; u[8 + bq] = r2; u[12 + bq] = r3;
    }
    __syncthreads();
#pragma unroll
    for (int c = 0; c < 4; c++) {
      float2 r0, r1, r2, r3;
      dft4(u[4 * c], u[4 * c + 1], u[4 * c + 2], u[4 * c + 3], r0, r1, r2, r3);
      buf[bi(j + (c) * p)] = r0; buf[bi(j + (c + 4) * p)] = r1; buf[bi(j + (c + 8) * p)] = r2; buf[bi(j + (c + 12) * p)] = r3;
    }
    __syncthreads();
  }
}

NI void phase0(PRef P, unsigned char* smem) {
  unsigned char* ws = P.ws;
  float* partial = (float*)(ws + OFF_PART);
  float* rmem = (float*)(ws + OFF_RMEM);
  float2* tw = (float2*)(ws + OFF_TW);
  float2* rope = (float2*)(ws + OFF_ROPE);
  float* h2 = (float*)(ws + OFF_H2);
  int tid = opaque_tid();
  int gtid = blockIdx.x * NT + tid, gsz = gridDim.x * NT;
  if (gtid == 0) *(int*)(P.ws + OFF_PROBE) = 1;
  for (int i = gtid; i < 4096; i += gsz) {
    float s, c; sincospif(2.0f * (float)i / 4096.0f, &s, &c);
    tw[i] = make_float2(c, -s);
  }
  for (int i = gtid; i < 1024; i += gsz) {
    int pos = i >> 4, f = i & 15;
    float inv = powf(10000.0f, -(float)f / 16.0f);
    float a = (float)pos * inv;
    rope[i] = make_float2(cosf(a), sinf(a));
  }
  int lane = tid & 63;
  int gw = gtid >> 6, nw = gsz >> 6;
  for (int row = gw; row < TOK + 2048; row += nw) {
    const float* src = row < TOK ? P.in[0] + (size_t)row * 1024 : P.in[1] + (size_t)(row - TOK) * 1024;
    float ss = 0.f;
#pragma unroll
    for (int i = 0; i < 4; i++) {
      float4 v = *(const float4*)(src + i * 256 + lane * 4);
      ss += v.x * v.x + v.y * v.y + v.z * v.z + v.w * v.w;
      if (row < TOK) *(uint2*)((bf16_t*)(P.ws + OFF_HB) + (size_t)row * 1024 + i * 256 + lane * 4) = make_uint2(pk2(v.x, v.y), pk2(v.z, v.w));
    }
#pragma unroll
    for (int o = 32; o > 0; o >>= 1) ss += __shfl_xor(ss, o);
    if (row < TOK) {
      if (lane < 16) partial[(size_t)row * 16 + lane] = lane == 0 ? ss : 0.f;
    } else if (lane == 0) rmem[row - TOK] = rsqrtf(ss * (1.f / 1024.f) + 1e-6f);
  }
  for (int it = gw; it < 2 * SEQ; it += nw) {
    int l = it >> 11, t = it & 2047;
    const float* w1 = P.in[7] + (size_t)l * 33 * 64;
    const float* b1 = P.in[8] + l * 64;
    const float* w2 = P.in[9] + (size_t)l * 64 * 64;
    const float* b2 = P.in[10] + l * 64;
    const float* fr = P.in[13] + l * 128;
    float zv = 0.f;
    if (lane == 0) zv = (float)t / 2047.0f;
    else if (lane < 33) {
      int kb = (lane - 1) & 15;
      float fk = 1e-4f + (float)kb * ((15.0f - 1e-4f) / 15.0f);
      float wv = 2.0f * 3.14159265358979323846f * (float)t / 2048.0f;
      float a = wv * fk;
      zv = lane <= 16 ? cosf(a) : -sinf(a);
    }
    float acc = b1[lane];
    for (int k = 0; k < 33; k++) acc += __shfl(zv, k) * w1[k * 64 + lane];
    float h1 = sinf(fr[lane] * acc);
    float acc2 = b2[lane];
    for (int k = 0; k < 64; k++) acc2 += __shfl(h1, k) * w2[k * 64 + lane];
    h2[(size_t)it * 64 + lane] = sinf(fr[64 + lane] * acc2);
  }
}

NI void hy_spectra_job(PRef P, int l, int c, unsigned char* smem) {
  float2* buf = (float2*)smem;
  float* w3s = (float*)(smem + 49664);
  float* red = (float*)(smem + 49664 + 1024);
  unsigned char* ws = P.ws;
  const float* h2 = (const float*)(ws + OFF_H2) + (size_t)l * SEQ * 64;
  const float2* tw = (const float2*)(ws + OFF_TW);
  float2* spec = (float2*)(ws + OFF_SPEC);
  const float* w3 = P.in[11] + (size_t)l * 64 * 2048;
  const float* b3 = P.in[12] + (size_t)l * 2048;
  int tid = opaque_tid();
  float2* twl = (float2*)(smem + 40960);
  __syncthreads();
  fft_fill_twl(twl, tw, tid);
  {
    int j = tid >> 6, k = tid & 63;
    w3s[j * 64 + k] = w3[(size_t)k * 2048 + j * 512 + c];
  }
  __syncthreads();
  float bb[4];
#pragma unroll
  for (int j = 0; j < 4; j++) bb[j] = b3[j * 512 + c];
  const float la = -4.605170185988091f / 0.3f, lb = -4.605170185988091f / 1.5f;
  float delta = fabsf(la + (lb - la) * ((float)c / 511.0f));
  float n0 = 0.f, n1 = 0.f;
#pragma unroll 1
  for (int i = 0; i < 8; i++) {
    int t = tid + 256 * i;
    float v[4] = {bb[0], bb[1], bb[2], bb[3]};
    const float4* hr = (const float4*)(h2 + (size_t)t * 64);
#pragma unroll 4
    for (int k4 = 0; k4 < 16; k4++) {
      float4 hv = hr[k4];
#pragma unroll
      for (int j = 0; j < 4; j++) {
        const float* wj = w3s + j * 64 + k4 * 4;
        v[j] += hv.x * wj[0] + hv.y * wj[1] + hv.z * wj[2] + hv.w * wj[3];
      }
    }
    float win = __expf(-((float)t / 2047.0f) * delta);
#pragma unroll
    for (int j = 0; j < 4; j++) v[j] *= win;
    buf[bi(t)] = make_float2(v[0], v[2]);
    n0 += fabsf(v[0]); n1 += fabsf(v[2]);
    if (t >= 1) { buf[bi(4096 - t)] = make_float2(v[1], v[3]); n0 += fabsf(v[1]); n1 += fabsf(v[3]); }
    else buf[bi(2048)] = make_float2(0.f, 0.f);
  }
#pragma unroll
  for (int o = 32; o > 0; o >>= 1) { n0 += __shfl_xor(n0, o); n1 += __shfl_xor(n1, o); }
  if ((tid & 63) == 0) { red[(tid >> 6)] = n0; red[4 + (tid >> 6)] = n1; }
  __syncthreads();
  float inv0 = 0.5f / (red[0] + red[1] + red[2] + red[3] + 1e-6f);
  float inv1 = 0.5f / (red[4] + red[5] + red[6] + red[7] + 1e-6f);
  fft4096(buf, tw, twl, tid);
#pragma unroll 2
  for (int i = 0; i < 16; i++) {
    int k = tid + 256 * i;
    float2 a = buf[bi(k)], b = buf[bi((4096 - k) & 4095)];
    if (k <= 2048) {
      spec[((size_t)c * 2 + 0) * 2049 + k] = make_float2((a.x + b.x) * inv0, (a.y - b.y) * inv0);
      spec[((size_t)c * 2 + 1) * 2049 + k] = make_float2((a.y + b.y) * inv1, -(a.x - b.x) * inv1);
    }
  }
  __syncthreads();
}

DI float hy_sc(const bf16_t* row, int t, float w0, float w1, float w2) {
  float a = t > 0 ? bf2f(row[t - 1]) : 0.f;
  float b = bf2f(row[t]);
  float d = t < SEQ - 1 ? bf2f(row[t + 1]) : 0.f;
  return w0 * a + w1 * b + w2 * d;
}
NI void hy_conv_job(PRef P, int l, int c, int pr, unsigned char* smem, bool dry) {
  float2* buf = (float2*)smem;
  unsigned char* ws = P.ws;
  const float2* tw = (const float2*)(ws + OFF_TW);
  const float2* H0 = (const float2*)(ws + OFF_SPEC) + ((size_t)c * 2) * 2049;
  const float2* H1 = H0 + 2049;
  bf16_t* hyT = (bf16_t*)(ws + OFF_HYT);
  const float* cw = P.in[6] + (size_t)l * 3 * 1536;
  const float* skip = P.in[14] + (size_t)l * 1024;
  int tid = opaque_tid();
  int b0 = 2 * pr, b1 = 2 * pr + 1;
  bf16_t* rv0 = hyT + ((size_t)b0 * 1536 + c) * SEQ;
  bf16_t* rv1 = hyT + ((size_t)b1 * 1536 + c) * SEQ;
  const bf16_t* rx10 = rv0 + (size_t)512 * SEQ; const bf16_t* rx11 = rv1 + (size_t)512 * SEQ;
  const bf16_t* rx20 = rv0 + (size_t)1024 * SEQ; const bf16_t* rx21 = rv1 + (size_t)1024 * SEQ;
  float wv0 = cw[c], wv1 = cw[1536 + c], wv2 = cw[3072 + c];
  float wa0 = cw[512 + c], wa1 = cw[1536 + 512 + c], wa2 = cw[3072 + 512 + c];
  float wb0 = cw[1024 + c], wb1 = cw[1536 + 1024 + c], wb2 = cw[3072 + 1024 + c];
  float sk0 = skip[c], sk1 = skip[512 + c];
  float va[8], vb[8];
  float2* twl = (float2*)(smem + 40960);
  __syncthreads();
  fft_fill_twl(twl, tw, tid);
#pragma unroll
  for (int i = 0; i < 8; i++) {
    int t = tid + 256 * i;
    va[i] = hy_sc(rv0, t, wv0, wv1, wv2);
    vb[i] = hy_sc(rv1, t, wv0, wv1, wv2);
    buf[bi(t)] = make_float2(va[i], vb[i]);
    buf[bi(t + 2048)] = make_float2(0.f, 0.f);
  }
  __syncthreads();
  fft4096(buf, tw, twl, tid);
  for (int i = 0; i < 16; i++) {
    int k = tid + 256 * i;
    float2 hk = k <= 2048 ? H0[k] : H0[4096 - k];
    if (k > 2048) hk.y = -hk.y;
    float2 w = cmul(buf[bi(k)], hk);
    buf[bi(k)] = make_float2(w.x, -w.y);
  }
  __syncthreads();
  fft4096(buf, tw, twl, tid);
  const float sc = 1.0f / 4096.0f;
#pragma unroll
  for (int i = 0; i < 8; i++) {
    int t = tid + 256 * i;
    float2 y = buf[bi(t)];
    float y0 = y.x * sc + va[i] * sk0;
    float y1 = -y.y * sc + vb[i] * sk0;
    float z0 = hy_sc(rx10, t, wa0, wa1, wa2) * y0;
    float z1 = hy_sc(rx11, t, wa0, wa1, wa2) * y1;
    va[i] = z0; vb[i] = z1;
    buf[bi(t)] = make_float2(z0, z1);
    buf[bi(t + 2048)] = make_float2(0.f, 0.f);
  }
  __syncthreads();
  fft4096(buf, tw, twl, tid);
  for (int i = 0; i < 16; i++) {
    int k = tid + 256 * i;
    float2 hk = k <= 2048 ? H1[k] : H1[4096 - k];
    if (k > 2048) hk.y = -hk.y;
    float2 w = cmul(buf[bi(k)], hk);
    buf[bi(k)] = make_float2(w.x, -w.y);
  }
  __syncthreads();
  fft4096(buf, tw, twl, tid);
#pragma unroll
  for (int i = 0; i < 8; i++) {
    int t = tid + 256 * i;
    float2 y = buf[bi(t)];
    float y0 = y.x * sc + va[i] * sk1;
    float y1 = -y.y * sc + vb[i] * sk1;
    float o0 = hy_sc(rx20, t, wb0, wb1, wb2) * y0;
    float o1 = hy_sc(rx21, t, wb0, wb1, wb2) * y1;
    va[i] = o0; vb[i] = o1;
  }
  __syncthreads();
#pragma unroll
  for (int i = 0; i < 8; i++) {
    int t = tid + 256 * i;
    if (!dry) { rv0[t] = (bf16_t)f2bf(va[i]); rv1[t] = (bf16_t)f2bf(vb[i]); }
  }
}


NI void wconv_job(PRef P, int it, unsigned char* smem) {
  int tid = opaque_tid();
  bf16_t* sW = (bf16_t*)smem;
  unsigned char* ws = P.ws;
  const float* src; const float* gain = nullptr; bf16_t* dst;
  int K = 1024, N = 1024, kt, nt, l;
  if (it < 1760) {
    l = it >= 880 ? 1 : 0; int r = it - l * 880;
    src = P.in[3] + (size_t)l * 1024 * NIN; gain = P.in[2] + l * 1024; dst = (bf16_t*)(ws + OFF_WB) + (size_t)l * WS_WIN; N = NIN; nt = r % 55; kt = r / 55;
  } else {
    int r = it - 1760; l = r >= NWL ? 1 : 0; r -= l * NWL;
    bf16_t* wo = (bf16_t*)P.out + (size_t)l * WO_LAYER;
    if (r < 128) { src = P.in[21] + (size_t)l * 1024 * 1024; dst = wo + WO_WOUT; nt = r & 7; kt = r >> 3; }
    else if (r < 256) { r -= 128; src = P.in[24] + (size_t)l * 1024 * 1024; gain = P.in[22] + l * 1024; dst = wo + WO_WQ; nt = r & 7; kt = r >> 3; }
    else if (r < 768) { r -= 256; src = P.in[31] + (size_t)l * 1024 * 4096; gain = P.in[30] + l * 1024; dst = wo + WO_W1; N = 4096; nt = r & 31; kt = r >> 5; }
    else if (r < 1280) { r -= 768; src = P.in[32] + (size_t)l * 4096 * 1024; dst = l == 0 ? wo + WO_W2 : (bf16_t*)(ws + OFF_WB) + WS_W2L1; K = 4096; nt = r & 7; kt = r >> 3; }
    else if (r < 1280 + 384) {
      r -= 1280; int which = r >> 7, rr = r & 127; nt = rr & 7; kt = rr >> 3;
      if (which == 0) { src = P.in[25]; dst = wo + WO_WK; gain = P.in[23] + l * 1024; }
      else if (which == 1) { src = P.in[26]; dst = wo + WO_WV; gain = P.in[23] + l * 1024; }
      else { src = P.in[27]; dst = wo + WO_WO; }
      src += (size_t)l * 1024 * 1024;
    } else {
      r -= 1280 + 384; int br = r >> 6, rr = r & 63; K = 512; nt = rr & 7; kt = rr >> 3;
      src = (br == 0 ? P.in[18] : br == 1 ? P.in[19] : P.in[20]) + (size_t)l * 512 * 1024; dst = wo + WO_BR + (size_t)br * 524288;
    }
  }
  int n0 = nt * 128, k0 = kt * 64;
  int valid = N - n0 < 128 ? N - n0 : 128;
  LdKMajF32<128> lw; lw.tid = tid; lw.p = src + n0; lw.ld = N; lw.gain = gain; lw.ncol = valid;
  lw.load(k0);
  __syncthreads();
  lw.store(sW);
  __syncthreads();
  int n = tid >> 1, half = tid & 1;
  if (n < valid) {
#pragma unroll
    for (int e = 0; e < 4; e++)
      *(uint4*)(dst + (size_t)(n0 + n) * K + k0 + half * 32 + e * 8) = *(const uint4*)(sW + swz_off(n, half * 32 + e * 8));
  }
}

NI void inproj_tile(PRef P, int l, const float* hsrc, int mt, int nt, unsigned char* smem) {
  int tid = opaque_tid();
  bf16_t* sW = (bf16_t*)smem; bf16_t* sA = (bf16_t*)(smem + 18432);
  unsigned char* ws = P.ws;
  const float* partial = (const float*)(ws + OFF_PART);
  int m0 = mt * 128, n0 = nt * 128;
  LdRowBf16<128> la; la.tid = tid; la.p = (const bf16_t*)(ws + OFF_HB) + (size_t)m0 * 1024; la.ld = 1024;
  LdRowBf16<128> lw; lw.tid = tid; lw.p = (const bf16_t*)(ws + OFF_WB) + (size_t)l * WS_WIN + (size_t)n0 * 1024; lw.ld = 1024;
  f32x4 acc[4][4]; zero_acc<4>(acc);
  gemm_kloop<4>(la, lw, 1024, acc, sW, sA);
  int lane = tid & 63, w = tid >> 6, r = lane & 15, q = lane >> 4, wn = w >> 1, wm = w & 1;
#pragma unroll
  for (int mi = 0; mi < 4; mi++) {
    int m = m0 + wm * 64 + mi * 16 + r;
    float rs = row_rstd(partial, m);
#pragma unroll
    for (int ni = 0; ni < 4; ni++) acc[ni][mi] *= rs;
  }
  if (nt <= 4) {
    const float* gn = (nt < 4 ? P.in[4] : P.in[5]) + l * 64;
    const float2* rope = (const float2*)(ws + OFF_ROPE);
    bf16_t* dst = nt < 4 ? (bf16_t*)(ws + OFF_Q) : (bf16_t*)(ws + OFF_K);
    int ldd = nt < 4 ? 512 : 128;
    int cbase = (nt < 4 ? nt * 128 : 0) + wn * 64;
    f32x4 g[4];
#pragma unroll
    for (int ni = 0; ni < 4; ni++) g[ni] = *(const f32x4*)(gn + ni * 16 + q * 4);
#pragma unroll
    for (int mi = 0; mi < 4; mi++) {
      int m = m0 + wm * 64 + mi * 16 + r;
      float ss = 0.f;
#pragma unroll
      for (int ni = 0; ni < 4; ni++)
#pragma unroll
        for (int j = 0; j < 4; j++) ss += acc[ni][mi][j] * acc[ni][mi][j];
      ss += __shfl_xor(ss, 16); ss += __shfl_xor(ss, 32);
      float rs = rsqrtf(ss * (1.f / 64.f) + 1e-6f);
      int t = m & 2047;
      int prow = t >> 6, pcol = t & 63;
      f32x4 y[4];
#pragma unroll
      for (int ni = 0; ni < 4; ni++) y[ni] = acc[ni][mi] * rs * g[ni];
      f32x4 o[4];
#pragma unroll
      for (int j = 0; j < 4; j++) {
        float2 cr = rope[prow * 16 + q * 4 + j];
        float2 cc = rope[pcol * 16 + q * 4 + j];
        o[0][j] = y[0][j] * cr.x - y[1][j] * cr.y;
        o[1][j] = y[0][j] * cr.y + y[1][j] * cr.x;
        o[2][j] = y[2][j] * cc.x - y[3][j] * cc.y;
        o[3][j] = y[2][j] * cc.y + y[3][j] * cc.x;
      }
#pragma unroll
      for (int ni = 0; ni < 4; ni++)
        *(uint2*)(dst + (size_t)m * ldd + cbase + ni * 16 + q * 4) = make_uint2(pk2(o[ni][0], o[ni][1]), pk2(o[ni][2], o[ni][3]));
    }
  } else if (nt <= 17) {
    bf16_t* dst; int chbase, nch;
    if (nt == 5) { dst = (bf16_t*)(ws + OFF_VT); chbase = 0; nch = 128; }
    else { dst = (bf16_t*)(ws + OFF_HYT); chbase = (nt - 6) * 128; nch = 1536; }
    bf16_t* sT = (bf16_t*)smem;
    __syncthreads();
#pragma unroll
    for (int mi = 0; mi < 4; mi++) {
      int tl = wm * 64 + mi * 16 + r;
#pragma unroll
      for (int ni = 0; ni < 4; ni++)
#pragma unroll
        for (int j = 0; j < 4; j++) sT[(wn * 64 + ni * 16 + q * 4 + j) * 136 + tl] = (bf16_t)f2bf(acc[ni][mi][j]);
    }
    __syncthreads();
    {
      int b = m0 >> 11, t0 = m0 & 2047;
#pragma unroll
      for (int i = 0; i < 8; i++) {
        int id = tid + 256 * i;
        int ch = id >> 4, c16 = id & 15;
        uint4 v = *(const uint4*)(sT + ch * 136 + c16 * 8);
        *(uint4*)(dst + ((size_t)b * nch + chbase + ch) * SEQ + t0 + c16 * 8) = v;
      }
    }
  } else if (nt <= 29) {
    bf16_t* dst; int ldd, cbase;
    if (nt <= 19) { dst = (bf16_t*)(ws + OFF_GQ); ldd = 256; cbase = (nt - 18) * 128; }
    else if (nt <= 21) { dst = (bf16_t*)(ws + OFF_GK); ldd = 256; cbase = (nt - 20) * 128; }
    else if (nt <= 25) { dst = (bf16_t*)(ws + OFF_GV); ldd = 512; cbase = (nt - 22) * 128; }
    else { dst = (bf16_t*)(ws + OFF_GO); ldd = 512; cbase = (nt - 26) * 128; }
    cbase += wn * 64;
#pragma unroll
    for (int mi = 0; mi < 4; mi++) {
      int m = m0 + wm * 64 + mi * 16 + r;
#pragma unroll
      for (int ni = 0; ni < 4; ni++)
        *(uint2*)(dst + (size_t)m * ldd + cbase + ni * 16 + q * 4) =
            make_uint2(pk2(acc[ni][mi][0], acc[ni][mi][1]), pk2(acc[ni][mi][2], acc[ni][mi][3]));
    }
  } else {
    float* dst = (float*)(ws + OFF_GLR);
    if (wn == 0) {
#pragma unroll
      for (int mi = 0; mi < 4; mi++) {
        int m = m0 + wm * 64 + mi * 16 + r;
#pragma unroll
        for (int ni = 0; ni < 2; ni++) *(f32x4*)(dst + (size_t)m * 32 + ni * 16 + q * 4) = acc[ni][mi];
      }
    }
  }
}

NI void attn_unit(PRef P, int u, unsigned char* smem) {
  bf16_t* sK = (bf16_t*)smem;
  bf16_t* sVT = (bf16_t*)(smem + 9216);
  unsigned char* ws = P.ws;
  bf16_t* qb = (bf16_t*)(ws + OFF_Q);
  const bf16_t* kb = (const bf16_t*)(ws + OFF_K);
  const bf16_t* vt = (const bf16_t*)(ws + OFF_VT);
  int b = u >> 7, head = (u >> 4) & 7, qt = u & 15, kvh = head >> 2;
  int tid = opaque_tid(), lane = tid & 63, w = tid >> 6, ql = lane & 31, hh = lane >> 5;
  int tok = b * SEQ + qt * 128 + w * 32 + ql;
  bf16x8 qf[4];
#pragma unroll
  for (int ks = 0; ks < 4; ks++) qf[ks] = *(const bf16x8*)(qb + (size_t)tok * 512 + head * 64 + ks * 16 + hh * 8);
  f32x16 o[2];
#pragma unroll
  for (int i = 0; i < 16; i++) { o[0][i] = 0.f; o[1][i] = 0.f; }
  float mrun = -1e30f, lrun = 0.f;
  const float cs = 0.125f * 1.44269504088896f;
  uint4 pk[2], pv[2];
  int lrow = tid >> 3, lch = tid & 7;
  const bf16_t* kbase = kb + (size_t)(b * SEQ) * 128 + kvh * 64;
  const bf16_t* vbase = vt + (size_t)((b * 2 + kvh) * 64) * SEQ;
#pragma unroll
  for (int i = 0; i < 2; i++) {
    pk[i] = *(const uint4*)(kbase + (size_t)(lrow + 32 * i) * 128 + lch * 8);
    pv[i] = *(const uint4*)(vbase + (size_t)(lrow + 32 * i) * SEQ + lch * 8);
  }
  for (int kt = 0; kt < 32; kt++) {
    __syncthreads();
#pragma unroll
    for (int i = 0; i < 2; i++) {
      *(uint4*)(sK + (lrow + 32 * i) * 72 + lch * 8) = pk[i];
      *(uint2*)(sVT + (lrow + 32 * i) * 68 + lch * 8) = make_uint2(pv[i].x, pv[i].y);
      *(uint2*)(sVT + (lrow + 32 * i) * 68 + lch * 8 + 4) = make_uint2(pv[i].z, pv[i].w);
    }
    __syncthreads();
    if (kt + 1 < 32) {
#pragma unroll
      for (int i = 0; i < 2; i++) {
        pk[i] = *(const uint4*)(kbase + (size_t)((kt + 1) * 64 + lrow + 32 * i) * 128 + lch * 8);
        pv[i] = *(const uint4*)(vbase + (size_t)(lrow + 32 * i) * SEQ + (kt + 1) * 64 + lch * 8);
      }
    }
    f32x16 s[2];
#pragma unroll
    for (int i = 0; i < 16; i++) { s[0][i] = 0.f; s[1][i] = 0.f; }
#pragma unroll
    for (int mt2 = 0; mt2 < 2; mt2++)
#pragma unroll
      for (int ks = 0; ks < 4; ks++) {
        bf16x8 a = *(const bf16x8*)(sK + (mt2 * 32 + ql) * 72 + ks * 16 + hh * 8);
        s[mt2] = __builtin_amdgcn_mfma_f32_32x32x16_bf16(a, qf[ks], s[mt2], 0, 0, 0);
      }
    float mloc = s[0][0];
#pragma unroll
    for (int i = 0; i < 16; i++) { mloc = fmaxf(mloc, s[0][i]); mloc = fmaxf(mloc, s[1][i]); }
    mloc = fmaxf(mloc, __shfl_xor(mloc, 32));
    float mnew = fmaxf(mrun, mloc);
    bool grow = mnew > mrun;
    float alpha = __builtin_amdgcn_exp2f((mrun - mnew) * cs);
    mrun = mnew;
    float ls = 0.f;
    float mb = mnew * cs;
#pragma unroll
    for (int i = 0; i < 16; i++) {
      s[0][i] = __builtin_amdgcn_exp2f(s[0][i] * cs - mb); s[1][i] = __builtin_amdgcn_exp2f(s[1][i] * cs - mb);
      ls += s[0][i] + s[1][i];
    }
    lrun = lrun * alpha + ls;
    if (__any(grow)) {
#pragma unroll
      for (int i = 0; i < 16; i++) { o[0][i] *= alpha; o[1][i] *= alpha; }
    }
#pragma unroll
    for (int mt2 = 0; mt2 < 2; mt2++)
#pragma unroll
      for (int s2 = 0; s2 < 2; s2++) {
        union { bf16x8 v; unsigned u[4]; } pb;
#pragma unroll
        for (int j = 0; j < 4; j++) pb.u[j] = pk2(s[mt2][8 * s2 + 2 * j], s[mt2][8 * s2 + 2 * j + 1]);
#pragma unroll
        for (int dt = 0; dt < 2; dt++) {
          const bf16_t* vp = sVT + (dt * 32 + ql) * 68 + mt2 * 32 + s2 * 16 + hh * 4;
          union { bf16x8 v; uint2 u[2]; } av;
          av.u[0] = *(const uint2*)vp; av.u[1] = *(const uint2*)(vp + 8);
          o[dt] = __builtin_amdgcn_mfma_f32_32x32x16_bf16(av.v, pb.v, o[dt], 0, 0, 0);
        }
      }
  }
  float lt = lrun + __shfl_xor(lrun, 32);
  float inv = 1.f / lt;
#pragma unroll
  for (int dt = 0; dt < 2; dt++)
#pragma unroll
    for (int g = 0; g < 4; g++) {
      int d = dt * 32 + 8 * g + 4 * hh;
      *(uint2*)((bf16_t*)(ws + OFF_OA) + (size_t)tok * 512 + head * 64 + d) =
          make_uint2(pk2(o[dt][4 * g] * inv, o[dt][4 * g + 1] * inv), pk2(o[dt][4 * g + 2] * inv, o[dt][4 * g + 3] * inv));
    }
}

NI void memkv_tile(PRef P, int l, int mt, int nt, unsigned char* smem) {
  int tid = opaque_tid();
  bf16_t* sW = (bf16_t*)smem; bf16_t* sA = (bf16_t*)(smem + 18432);
  unsigned char* ws = P.ws;
  const float* rmem = (const float*)(ws + OFF_RMEM);
  int m0 = mt * 128;
  LdRowF32<128> la; la.tid = tid; la.p = P.in[1] + (size_t)m0 * 1024; la.ld = 1024; la.gain = nullptr;
  LdRowBf16<128> lw; lw.tid = tid; lw.p = (const bf16_t*)P.out + (size_t)l * WO_LAYER + (nt < 8 ? WO_WK : WO_WV) + (size_t)(nt & 7) * 128 * 1024; lw.ld = 1024;
  f32x4 acc[4][4]; zero_acc<4>(acc);
  gemm_kloop<4>(la, lw, 1024, acc, sW, sA);
  int lane = tid & 63, w = tid >> 6, r = lane & 15, q = lane >> 4, wn = w >> 1, wm = w & 1;
  bf16_t* mk = (bf16_t*)(ws + OFF_MEMK);
  bf16_t* mvt = (bf16_t*)(ws + OFF_MEMVT);
#pragma unroll
  for (int mi = 0; mi < 4; mi++) {
    int m = m0 + wm * 64 + mi * 16 + r;
    float rs = rmem[m];
#pragma unroll
    for (int ni = 0; ni < 4; ni++) {
      f32x4 v = acc[ni][mi] * rs;
      int n = (nt & 7) * 128 + wn * 64 + ni * 16 + q * 4;
      if (nt < 8) {
        *(uint2*)(mk + (size_t)m * 1024 + n) = make_uint2(pk2(v[0], v[1]), pk2(v[2], v[3]));
      } else {
        int b = m >> 8, key = m & 255;
#pragma unroll
        for (int j = 0; j < 4; j++) {
          int nn = n + j; int h = nn >> 8, d = nn & 255;
          mvt[(((size_t)b * 4 + h) * 256 + d) * 256 + key] = (bf16_t)f2bf(v[j]);
        }
      }
    }
  }
}

DI float logsigf(float x) { return fminf(x, 0.f) - log1pf(__expf(-fabsf(x))); }
DI void gla_gates(PRef P, int l, int h, int t0, int tid, const float* glrS, float* psum, float (&g)[32], float& off, float& total) {
  int d = tid & 63, dir = (tid >> 6) & 1, half = tid >> 7;
  const float* wl = P.in[15] + ((size_t)(l * 2 + dir) * 16) * 256 + h * 64 + d;
  float wr[16];
#pragma unroll
  for (int r = 0; r < 16; r++) wr[r] = wl[r * 256];
  float bias = P.in[16][(size_t)(l * 2 + dir) * 256 + h * 64 + d];
  float ps = 0.f;
#pragma unroll
  for (int j = 0; j < 32; j++) {
    int i = 32 * half + j;
    int c = dir ? 63 - i : i;
    const float* lr = glrS + c * 32 + dir * 16;
    float lg = bias;
#pragma unroll
    for (int r = 0; r < 16; r++) lg += lr[r] * wr[r];
    g[j] = logsigf(lg) * (1.f / 16.f);
    ps += g[j];
  }
  psum[(dir * 2 + half) * 64 + d] = ps;
  __syncthreads();
  float p0 = psum[(dir * 2) * 64 + d], p1 = psum[(dir * 2 + 1) * 64 + d];
  off = half ? p0 : 0.f;
  total = p0 + p1;
}
NI void gla_state_unit(PRef P, int l, int u, unsigned char* smem) {
  bf16_t* sVT = (bf16_t*)smem;
  bf16_t* sKK = (bf16_t*)(smem + 18432);
  float* glrS = (float*)(smem + 36864);
  float* psum = (float*)(smem + 45056);
  unsigned char* ws = P.ws;
  const bf16_t* gk = (const bf16_t*)(ws + OFF_GK);
  const bf16_t* gv = (const bf16_t*)(ws + OFF_GV);
  const float* glr = (const float*)(ws + OFF_GLR);
  float* decay = (float*)(ws + OFF_DECAY);
  bf16_t* gst = (bf16_t*)(ws + OFF_GST);
  int bh = u >> 5, m = u & 31, b = bh >> 2, h = bh & 3;
  int t0 = b * SEQ + m * 64;
  int tid = opaque_tid();
  __syncthreads();
#pragma unroll
  for (int i = 0; i < 8; i++) { int idx = tid + 256 * i; glrS[idx] = glr[(size_t)t0 * 32 + idx]; }
  {
    LdKMajBf16<128, false> lv; lv.tid = tid; lv.p = gv + (size_t)t0 * 512 + h * 128; lv.ld = 512;
    lv.load(0); lv.store(sVT);
  }
  __syncthreads();
  {
    float g[32], off, total;
    gla_gates(P, l, h, t0, tid, glrS, psum, g, off, total);
    int d = tid & 63, dir = (tid >> 6) & 1, half = tid >> 7;
    if (half == 0) decay[((size_t)u * 2 + dir) * 64 + d] = __expf(total);
    float val[32];
    float run = off;
#pragma unroll
    for (int j = 0; j < 32; j++) {
      int i = 32 * half + j;
      int c = dir ? 63 - i : i;
      run += g[j];
      float kv = bf2f(gk[(size_t)(t0 + c) * 256 + h * 64 + d]);
      val[j] = kv * __expf(total - run);
    }
    int cbase = dir ? 32 * (1 - half) : 32 * half;
#pragma unroll
    for (int mq = 0; mq < 4; mq++) {
      unsigned pw[4];
#pragma unroll
      for (int e = 0; e < 4; e++) {
        int jj = mq * 8 + e * 2;
        float a0 = dir ? val[31 - jj] : val[jj];
        float a1 = dir ? val[30 - jj] : val[jj + 1];
        pw[e] = pk2(a0, a1);
      }
      *(uint4*)(sKK + (dir * 64 + d) * 72 + cbase + mq * 8) = make_uint4(pw[0], pw[1], pw[2], pw[3]);
    }
  }
  __syncthreads();
  int lane = tid & 63, w = tid >> 6, r = lane & 15, q = lane >> 4;
  f32x4 acc[2][4][2];
#pragma unroll
  for (int a = 0; a < 2; a++)
#pragma unroll
    for (int bq = 0; bq < 4; bq++)
#pragma unroll
      for (int cq = 0; cq < 2; cq++) acc[a][bq][cq] = (f32x4){0.f, 0.f, 0.f, 0.f};
#pragma unroll
  for (int kk = 0; kk < 2; kk++) {
    bf16x8 bv[2];
#pragma unroll
    for (int et = 0; et < 2; et++) bv[et] = *(const bf16x8*)(sVT + (32 * w + et * 16 + r) * 72 + kk * 32 + q * 8);
#pragma unroll
    for (int dir = 0; dir < 2; dir++)
#pragma unroll
      for (int dt = 0; dt < 4; dt++) {
        bf16x8 a = *(const bf16x8*)(sKK + (dir * 64 + dt * 16 + r) * 72 + kk * 32 + q * 8);
#pragma unroll
        for (int et = 0; et < 2; et++) acc[dir][dt][et] = __builtin_amdgcn_mfma_f32_16x16x32_bf16(a, bv[et], acc[dir][dt][et], 0, 0, 0);
      }
  }
#pragma unroll
  for (int dir = 0; dir < 2; dir++)
#pragma unroll
    for (int dt = 0; dt < 4; dt++)
#pragma unroll
      for (int et = 0; et < 2; et++) {
        int e = 32 * w + et * 16 + r, d = dt * 16 + q * 4;
        f32x4 v = acc[dir][dt][et];
        *(uint2*)(gst + (((size_t)u * 2 + dir) * 128 + e) * 64 + d) = make_uint2(pk2(v[0], v[1]), pk2(v[2], v[3]));
      }
}

NI void gla_scan_unit(PRef P, int su, bool dry) {
  unsigned char* ws = P.ws;
  const float* decay = (const float*)(ws + OFF_DECAY);
  bf16_t* gst = (bf16_t*)(ws + OFF_GST);
  int id = su * 256 + opaque_tid();
  int d4 = id & 15, e = (id >> 4) & 127, dir = (id >> 11) & 1, bh = id >> 12;
  float S0 = 0.f, S1 = 0.f, S2 = 0.f, S3 = 0.f;
#pragma unroll 1
  for (int s0 = 0; s0 < 32; s0 += 8) {
    uint2 ds[8]; float4 dc[8];
#pragma unroll
    for (int i = 0; i < 8; i++) {
      int m = dir ? 31 - (s0 + i) : s0 + i;
      int u = bh * 32 + m;
      ds[i] = *(const uint2*)(gst + (((size_t)u * 2 + dir) * 128 + e) * 64 + d4 * 4);
      dc[i] = *(const float4*)(decay + ((size_t)u * 2 + dir) * 64 + d4 * 4);
    }
#pragma unroll
    for (int i = 0; i < 8; i++) {
      int m = dir ? 31 - (s0 + i) : s0 + i;
      int u = bh * 32 + m;
      bf16_t* ptr = gst + (((size_t)u * 2 + dir) * 128 + e) * 64 + d4 * 4;
      if (!dry) *(uint2*)ptr = make_uint2(pk2(S0, S1), pk2(S2, S3));
      S0 = dc[i].x * S0 + bflo(ds[i].x); S1 = dc[i].y * S1 + bfhi(ds[i].x);
      S2 = dc[i].z * S2 + bflo(ds[i].y); S3 = dc[i].w * S3 + bfhi(ds[i].y);
    }
  }
}

NI void gla_out_unit(PRef P, int l, int u, unsigned char* smem, bool dry) {
  bf16_t* sQ = (bf16_t*)smem;
  bf16_t* sK = (bf16_t*)(smem + 18432);
  bf16_t* sVT = (bf16_t*)(smem + 36864);
  float* glrS = (float*)(smem + 36864);
  float* psum = (float*)(smem + 36864 + 8192);
  float* red = (float*)(smem + 55296);
  unsigned char* ws = P.ws;
  const bf16_t* gq = (const bf16_t*)(ws + OFF_GQ);
  const bf16_t* gk = (const bf16_t*)(ws + OFF_GK);
  const bf16_t* gv = (const bf16_t*)(ws + OFF_GV);
  bf16_t* go = (bf16_t*)(ws + OFF_GO);
  const float* glr = (const float*)(ws + OFF_GLR);
  const bf16_t* gst = (const bf16_t*)(ws + OFF_GST);
  int bh = u >> 5, m = u & 31, b = bh >> 2, h = bh & 3;
  int t0 = b * SEQ + m * 64;
  int tid = opaque_tid();
  __syncthreads();
#pragma unroll
  for (int i = 0; i < 8; i++) { int idx = tid + 256 * i; glrS[idx] = glr[(size_t)t0 * 32 + idx]; }
  __syncthreads();
  {
    float g[32], off, total;
    gla_gates(P, l, h, t0, tid, glrS, psum, g, off, total);
    int d = tid & 63, dir = (tid >> 6) & 1, half = tid >> 7;
    float run = off;
#pragma unroll
    for (int j = 0; j < 32; j++) {
      int i = 32 * half + j;
      int c = dir ? 63 - i : i;
      run += g[j];
      float qv = bf2f(gq[(size_t)(t0 + c) * 256 + h * 64 + d]) * 0.125f;
      float kv = bf2f(gk[(size_t)(t0 + c) * 256 + h * 64 + d]);
      sQ[(dir * 64 + c) * 72 + d] = (bf16_t)f2bf(qv * __expf(run));
      sK[(dir * 64 + c) * 72 + d] = (bf16_t)f2bf(kv * __expf(-run));
    }
  }
  __syncthreads();
  {
    LdKMajBf16<128, false> lv; lv.tid = tid; lv.p = gv + (size_t)t0 * 512 + h * 128; lv.ld = 512;
    lv.load(0); lv.store(sVT);
  }
  __syncthreads();
  int lane = tid & 63, w = tid >> 6, r = lane & 15, q = lane >> 4;
  f32x4 o[2][4];
#pragma unroll
  for (int a = 0; a < 2; a++)
#pragma unroll
    for (int c = 0; c < 4; c++) o[a][c] = (f32x4){0.f, 0.f, 0.f, 0.f};
#pragma unroll
  for (int dir = 0; dir < 2; dir++) {
    f32x4 at[4][4];
#pragma unroll
    for (int a = 0; a < 4; a++)
#pragma unroll
      for (int c = 0; c < 4; c++) at[a][c] = (f32x4){0.f, 0.f, 0.f, 0.f};
#pragma unroll
    for (int kk = 0; kk < 2; kk++) {
      bf16x8 ka[4], qb[4];
#pragma unroll
      for (int st = 0; st < 4; st++) ka[st] = *(const bf16x8*)(sK + (dir * 64 + st * 16 + r) * 72 + kk * 32 + q * 8);
#pragma unroll
      for (int ct = 0; ct < 4; ct++) qb[ct] = *(const bf16x8*)(sQ + (dir * 64 + ct * 16 + r) * 72 + kk * 32 + q * 8);
#pragma unroll
      for (int st = 0; st < 4; st++)
#pragma unroll
        for (int ct = 0; ct < 4; ct++) at[st][ct] = __builtin_amdgcn_mfma_f32_16x16x32_bf16(ka[st], qb[ct], at[st][ct], 0, 0, 0);
    }
#pragma unroll
    for (int i = 0; i < 2; i++) {
      bf16x8 av[2];
#pragma unroll
      for (int et = 0; et < 2; et++) {
        const bf16_t* vp = sVT + (32 * w + et * 16 + r) * 72 + 32 * i + 4 * q;
        union { bf16x8 v; uint2 u2[2]; } t; t.u2[0] = *(const uint2*)vp; t.u2[1] = *(const uint2*)(vp + 16);
        av[et] = t.v;
      }
#pragma unroll
      for (int ct = 0; ct < 4; ct++) {
        int c = 16 * ct + r;
        float pv[8];
#pragma unroll
        for (int hf = 0; hf < 2; hf++)
#pragma unroll
          for (int j = 0; j < 4; j++) {
            int s = 16 * (2 * i + hf) + 4 * q + j;
            bool keep = dir == 0 ? (s <= c) : (s > c);
            pv[hf * 4 + j] = keep ? at[2 * i + hf][ct][j] : 0.f;
          }
        union { bf16x8 v; unsigned u4[4]; } pb;
#pragma unroll
        for (int j = 0; j < 4; j++) pb.u4[j] = pk2(pv[2 * j], pv[2 * j + 1]);
#pragma unroll
        for (int et = 0; et < 2; et++) o[et][ct] = __builtin_amdgcn_mfma_f32_16x16x32_bf16(av[et], pb.v, o[et][ct], 0, 0, 0);
      }
    }
#pragma unroll
    for (int kk = 0; kk < 2; kk++) {
      bf16x8 sa[2];
#pragma unroll
      for (int et = 0; et < 2; et++)
        sa[et] = *(const bf16x8*)(gst + (((size_t)u * 2 + dir) * 128 + 32 * w + et * 16 + r) * 64 + kk * 32 + q * 8);
#pragma unroll
      for (int ct = 0; ct < 4; ct++) {
        bf16x8 qb = *(const bf16x8*)(sQ + (dir * 64 + ct * 16 + r) * 72 + kk * 32 + q * 8);
#pragma unroll
        for (int et = 0; et < 2; et++) o[et][ct] = __builtin_amdgcn_mfma_f32_16x16x32_bf16(sa[et], qb, o[et][ct], 0, 0, 0);
      }
    }
  }
#pragma unroll
  for (int ct = 0; ct < 4; ct++) {
    float ss = 0.f;
#pragma unroll
    for (int et = 0; et < 2; et++)
#pragma unroll
      for (int j = 0; j < 4; j++) ss += o[et][ct][j] * o[et][ct][j];
    ss += __shfl_xor(ss, 16); ss += __shfl_xor(ss, 32);
    if (q == 0) red[w * 64 + ct * 16 + r] = ss;
  }
  __syncthreads();
  const float* onorm = P.in[17] + l * 128;
#pragma unroll
  for (int ct = 0; ct < 4; ct++) {
    int c = ct * 16 + r;
    float tot = red[c] + red[64 + c] + red[128 + c] + red[192 + c];
    float rs = rsqrtf(tot * (1.f / 128.f) + 1e-6f);
#pragma unroll
    for (int et = 0; et < 2; et++) {
      int e = 32 * w + et * 16 + 4 * q;
      f32x4 gn = *(const f32x4*)(onorm + e);
      bf16_t* gp = go + (size_t)(t0 + c) * 512 + h * 128 + e;
      uint2 gr = *(const uint2*)gp;
      float g0 = bflo(gr.x), g1 = bfhi(gr.x), g2 = bflo(gr.y), g3 = bfhi(gr.y);
      float y0 = o[et][ct][0] * rs * gn[0] * g0 * sigmoidf_(g0);
      float y1 = o[et][ct][1] * rs * gn[1] * g1 * sigmoidf_(g1);
      float y2 = o[et][ct][2] * rs * gn[2] * g2 * sigmoidf_(g2);
      float y3 = o[et][ct][3] * rs * gn[3] * g3 * sigmoidf_(g3);
      if (!dry) *(uint2*)gp = make_uint2(pk2(y0, y1), pk2(y2, y3));
    }
  }
}

NI void merge_tile(PRef P, int l, const float* hsrc, int mt, int nt, unsigned char* smem) {
  int tid = opaque_tid();
  bf16_t* sW = (bf16_t*)smem; bf16_t* sA = (bf16_t*)(smem + 18432);
  uint4* gslot = (uint4*)(smem + 36864) + tid * 4;
  unsigned char* ws = P.ws;
  const float* partial = (const float*)(ws + OFF_PART);
  int m0 = mt * 128, n0 = nt * 128;
  int lane = tid & 63, w = tid >> 6, r = lane & 15, q = lane >> 4, wn = w >> 1, wm = w & 1;
  f32x4 mix[4][4]; zero_acc<4>(mix);
#pragma unroll 1
  for (int br = 0; br < 3; br++) {
    f32x4 acc[4][4]; zero_acc<4>(acc);
    {
      int tid = opaque_tid();
      LdRowBf16<128> la; la.tid = tid; la.p = (const bf16_t*)(ws + OFF_HB) + (size_t)m0 * 1024; la.ld = 1024;
      LdRowBf16<128> lw; lw.tid = tid; lw.p = (const bf16_t*)(ws + OFF_WB) + (size_t)l * WS_WIN + (size_t)(3872 + br * 1024 + n0) * 1024; lw.ld = 1024;
      gemm_kloop<4>(la, lw, 1024, acc, sW, sA);
    }
#pragma unroll
    for (int mi = 0; mi < 4; mi++) {
      float rs = row_rstd(partial, m0 + wm * 64 + mi * 16 + r);
      unsigned pw[4];
#pragma unroll
      for (int ni = 0; ni < 4; ni++) {
        f32x4 v = acc[ni][mi] * rs;
        unsigned b0 = (unsigned)(sigmoidf_(v[0]) * 255.f + 0.5f), b1 = (unsigned)(sigmoidf_(v[1]) * 255.f + 0.5f);
        unsigned b2 = (unsigned)(sigmoidf_(v[2]) * 255.f + 0.5f), b3 = (unsigned)(sigmoidf_(v[3]) * 255.f + 0.5f);
        pw[ni] = b0 | (b1 << 8) | (b2 << 16) | (b3 << 24);
      }
      gslot[mi] = make_uint4(pw[0], pw[1], pw[2], pw[3]);
    }
    zero_acc<4>(acc);
    {
      int tid = opaque_tid();
      LdRowBf16<128> lw; lw.tid = tid; lw.p = (const bf16_t*)P.out + (size_t)l * WO_LAYER + WO_BR + (size_t)br * 524288 + (size_t)n0 * 512; lw.ld = 512;
      if (br == 1) {
        int b = m0 >> 11, t = m0 & 2047;
        LdKMajBf16<128> la; la.tid = tid; la.p = (const bf16_t*)(ws + OFF_HYT) + (size_t)b * 1536 * SEQ + t; la.ld = SEQ;
        gemm_kloop<4>(la, lw, 512, acc, sW, sA);
      } else {
        LdRowBf16<128> la; la.tid = tid; la.p = (const bf16_t*)(ws + (br == 0 ? OFF_OA : OFF_GO)) + (size_t)m0 * 512; la.ld = 512;
        gemm_kloop<4>(la, lw, 512, acc, sW, sA);
      }
    }
#pragma unroll
    for (int mi = 0; mi < 4; mi++) {
      uint4 gw = gslot[mi];
      unsigned pw[4] = {gw.x, gw.y, gw.z, gw.w};
#pragma unroll
      for (int ni = 0; ni < 4; ni++) {
        const float sc = 1.f / 255.f;
        mix[ni][mi][0] += (float)(pw[ni] & 255u) * sc * acc[ni][mi][0];
        mix[ni][mi][1] += (float)((pw[ni] >> 8) & 255u) * sc * acc[ni][mi][1];
        mix[ni][mi][2] += (float)((pw[ni] >> 16) & 255u) * sc * acc[ni][mi][2];
        mix[ni][mi][3] += (float)(pw[ni] >> 24) * sc * acc[ni][mi][3];
      }
    }
  }
  bf16_t* dst = (bf16_t*)(ws + OFF_MIXED);
#pragma unroll
  for (int mi = 0; mi < 4; mi++) {
    int m = m0 + wm * 64 + mi * 16 + r;
#pragma unroll
    for (int ni = 0; ni < 4; ni++)
      *(uint2*)(dst + (size_t)m * 1024 + n0 + wn * 64 + ni * 16 + q * 4) =
          make_uint2(pk2(mix[ni][mi][0], mix[ni][mi][1]), pk2(mix[ni][mi][2], mix[ni][mi][3]));
  }
}

template <bool WBF> NI void resid_tile(PRef P, const bf16_t* A, int lda, int K, const float* W, const bf16_t* Wt, bool final_out, int mt, int nt, unsigned char* smem, bool dry) {
  int tid = opaque_tid();
  bf16_t* sW = (bf16_t*)smem; bf16_t* sA = (bf16_t*)(smem + 18432);
  unsigned char* ws = P.ws;
  float* partial = (float*)(ws + OFF_PART);
  bf16_t* hb = (bf16_t*)(ws + OFF_HB);
  int m0 = mt * 128, n0 = nt * 128;
  LdRowBf16<128> la; la.tid = tid; la.p = A + (size_t)m0 * lda; la.ld = lda;
  f32x4 acc[4][4]; zero_acc<4>(acc);
  if constexpr (WBF) {
    LdRowBf16<128> lw; lw.tid = tid; lw.p = Wt + (size_t)n0 * K; lw.ld = K;
    gemm_kloop<4>(la, lw, K, acc, sW, sA);
  } else {
    LdKMajF32<128> lw; lw.tid = tid; lw.p = W + n0; lw.ld = 1024;
    gemm_kloop<4>(la, lw, K, acc, sW, sA);
  }
  int lane = tid & 63, w = tid >> 6, r = lane & 15, q = lane >> 4, wn = w >> 1, wm = w & 1;
#pragma unroll
  for (int mi = 0; mi < 4; mi++) {
    int m = m0 + wm * 64 + mi * 16 + r;
    float ss = 0.f;
#pragma unroll
    for (int ni = 0; ni < 4; ni++) {
      size_t off = (size_t)m * 1024 + n0 + wn * 64 + ni * 16 + q * 4;
      uint2 ho = *(const uint2*)(hb + off);
      f32x4 hv = acc[ni][mi];
      hv[0] += bflo(ho.x); hv[1] += bfhi(ho.x); hv[2] += bflo(ho.y); hv[3] += bfhi(ho.y);
      if (!dry) {
        if (final_out) *(f32x4*)(P.out + off) = hv;
        else *(uint2*)(hb + off) = make_uint2(pk2(hv[0], hv[1]), pk2(hv[2], hv[3]));
      }
      ss += hv[0] * hv[0] + hv[1] * hv[1] + hv[2] * hv[2] + hv[3] * hv[3];
    }
    ss += __shfl_xor(ss, 16); ss += __shfl_xor(ss, 32);
    if (q == 0 && !dry) partial[(size_t)m * 16 + nt * 2 + wn] = ss;
  }
}

NI void resid_tile256(PRef P, const bf16_t* A, int lda, int K, const bf16_t* Wt, bool final_out, int mt, int nt, unsigned char* smem, bool dry) {
  int tid = opaque_tid();
  bf16_t* sW = (bf16_t*)smem; bf16_t* sA = (bf16_t*)(smem + 18432);
  unsigned char* ws = P.ws;
  float* partial = (float*)(ws + OFF_PART);
  bf16_t* hb = (bf16_t*)(ws + OFF_HB);
  int m0 = mt * 256, n0 = nt * 128;
  LdRowBf16<256> la; la.tid = tid; la.p = A + (size_t)m0 * lda; la.ld = lda;
  f32x4 acc[4][8]; zero_acc<8>(acc);
  {
    LdRowBf16<128> lw; lw.tid = tid; lw.p = Wt + (size_t)n0 * K; lw.ld = K;
    gemm_kloop<8>(la, lw, K, acc, sW, sA);
  }
  int lane = tid & 63, w = tid >> 6, r = lane & 15, q = lane >> 4, wn = w >> 1, wm = w & 1;
#pragma unroll
  for (int mi = 0; mi < 8; mi++) {
    int m = m0 + wm * 128 + mi * 16 + r;
    float ss = 0.f;
#pragma unroll
    for (int ni = 0; ni < 4; ni++) {
      size_t off = (size_t)m * 1024 + n0 + wn * 64 + ni * 16 + q * 4;
      uint2 ho = *(const uint2*)(hb + off);
      f32x4 hv = acc[ni][mi];
      hv[0] += bflo(ho.x); hv[1] += bfhi(ho.x); hv[2] += bflo(ho.y); hv[3] += bfhi(ho.y);
      if (!dry) {
        if (final_out) *(f32x4*)(P.out + off) = hv;
        else *(uint2*)(hb + off) = make_uint2(pk2(hv[0], hv[1]), pk2(hv[2], hv[3]));
      }
      ss += hv[0] * hv[0] + hv[1] * hv[1] + hv[2] * hv[2] + hv[3] * hv[3];
    }
    ss += __shfl_xor(ss, 16); ss += __shfl_xor(ss, 32);
    if (q == 0 && !dry) partial[(size_t)m * 16 + nt * 2 + wn] = ss;
  }
}

NI void normed_tile(PRef P, const bf16_t* Wt, bf16_t* dst, int ldd, int mode, int mt, int nt, unsigned char* smem) {
  int tid = opaque_tid();
  bf16_t* sW = (bf16_t*)smem; bf16_t* sA = (bf16_t*)(smem + 18432);
  unsigned char* ws = P.ws;
  const float* partial = (const float*)(ws + OFF_PART);
  int m0 = mt * 128, n0 = nt * 128;
  LdRowBf16<128> la; la.tid = tid; la.p = (const bf16_t*)(ws + OFF_HB) + (size_t)m0 * 1024; la.ld = 1024;
  LdRowBf16<128> lw; lw.tid = tid; lw.p = Wt + (size_t)n0 * 1024; lw.ld = 1024;
  f32x4 acc[4][4]; zero_acc<4>(acc);
  gemm_kloop<4>(la, lw, 1024, acc, sW, sA);
  int lane = tid & 63, w = tid >> 6, r = lane & 15, q = lane >> 4, wn = w >> 1, wm = w & 1;
#pragma unroll
  for (int mi = 0; mi < 4; mi++) {
    int m = m0 + wm * 64 + mi * 16 + r;
    float rs = row_rstd(partial, m);
#pragma unroll
    for (int ni = 0; ni < 4; ni++) {
      f32x4 v = acc[ni][mi] * rs;
      if (mode == 1) {
#pragma unroll
        for (int j = 0; j < 4; j++) { float x = fmaxf(v[j], 0.f); v[j] = x * x; }
      }
      *(uint2*)(dst + (size_t)m * ldd + n0 + wn * 64 + ni * 16 + q * 4) = make_uint2(pk2(v[0], v[1]), pk2(v[2], v[3]));
    }
  }
}

NI void normed_tile256(PRef P, const bf16_t* Wt, bf16_t* dst, int ldd, int mode, int mt, int nt, unsigned char* smem) {
  int tid = opaque_tid();
  bf16_t* sW = (bf16_t*)smem; bf16_t* sA = (bf16_t*)(smem + 18432);
  unsigned char* ws = P.ws;
  const float* partial = (const float*)(ws + OFF_PART);
  int m0 = mt * 256, n0 = nt * 128;
  LdRowBf16<256> la; la.tid = tid; la.p = (const bf16_t*)(ws + OFF_HB) + (size_t)m0 * 1024; la.ld = 1024;
  LdRowBf16<128> lw; lw.tid = tid; lw.p = Wt + (size_t)n0 * 1024; lw.ld = 1024;
  f32x4 acc[4][8]; zero_acc<8>(acc);
  gemm_kloop<8>(la, lw, 1024, acc, sW, sA);
  int lane = tid & 63, w = tid >> 6, r = lane & 15, q = lane >> 4, wn = w >> 1, wm = w & 1;
#pragma unroll
  for (int mi = 0; mi < 8; mi++) {
    int m = m0 + wm * 128 + mi * 16 + r;
    float rs = row_rstd(partial, m);
#pragma unroll
    for (int ni = 0; ni < 4; ni++) {
      f32x4 v = acc[ni][mi] * rs;
      if (mode == 1) {
#pragma unroll
        for (int j = 0; j < 4; j++) { float x = fmaxf(v[j], 0.f); v[j] = x * x; }
      }
      *(uint2*)(dst + (size_t)m * ldd + n0 + wn * 64 + ni * 16 + q * 4) = make_uint2(pk2(v[0], v[1]), pk2(v[2], v[3]));
    }
  }
}

NI void xattn_unit(PRef P, int l, int u, unsigned char* smem) {
  bf16_t* sK = (bf16_t*)smem;
  float* rkS = (float*)(smem + 36864);
  unsigned char* ws = P.ws;
  const bf16_t* xq = (const bf16_t*)(ws + OFF_XQ);
  const bf16_t* mk = (const bf16_t*)(ws + OFF_MEMK);
  const bf16_t* mvt = (const bf16_t*)(ws + OFF_MEMVT);
  bf16_t* xo = (bf16_t*)(ws + OFF_XO);
  const float* qn = P.in[28] + l * 256;
  const float* kn = P.in[29] + l * 256;
  int bh = u >> 5, qt = u & 31, b = bh >> 2, h = bh & 3;
  int tid = opaque_tid(), lane = tid & 63, w = tid >> 6, r = lane & 15, q = lane >> 4;
  int tok = b * SEQ + qt * 64 + w * 16 + r;
  __syncthreads();
  {
    const uint4* kr = (const uint4*)(mk + (size_t)(b * 256 + tid) * 1024 + h * 256);
    float ss = 0.f;
#pragma unroll 8
    for (int i = 0; i < 32; i++) {
      uint4 v = kr[i];
      ss += bflo(v.x) * bflo(v.x) + bfhi(v.x) * bfhi(v.x) + bflo(v.y) * bflo(v.y) + bfhi(v.y) * bfhi(v.y)
          + bflo(v.z) * bflo(v.z) + bfhi(v.z) * bfhi(v.z) + bflo(v.w) * bflo(v.w) + bfhi(v.w) * bfhi(v.w);
    }
    rkS[tid] = rsqrtf(ss * (1.f / 256.f) + 1e-6f);
  }
  f32x4 s[16];
#pragma unroll
  for (int a = 0; a < 16; a++) s[a] = (f32x4){0.f, 0.f, 0.f, 0.f};
  float qss = 0.f;
  int lrow = tid >> 3, lch = tid & 7;
#pragma unroll 1
  for (int dc = 0; dc < 4; dc++) {
    __syncthreads();
    {
      f32x4 ga = *(const f32x4*)(qn + dc * 64 + lch * 8), gb = *(const f32x4*)(qn + dc * 64 + lch * 8 + 4);
      f32x4 ka = *(const f32x4*)(kn + dc * 64 + lch * 8), kb2 = *(const f32x4*)(kn + dc * 64 + lch * 8 + 4);
      ga *= ka; gb *= kb2;
#pragma unroll
      for (int i = 0; i < 8; i++) {
        int row = lrow + 32 * i;
        uint4 v = *(const uint4*)(mk + (size_t)(b * 256 + row) * 1024 + h * 256 + dc * 64 + lch * 8);
        uint4 o;
        o.x = pk2(bflo(v.x) * ga[0], bfhi(v.x) * ga[1]); o.y = pk2(bflo(v.y) * ga[2], bfhi(v.y) * ga[3]);
        o.z = pk2(bflo(v.z) * gb[0], bfhi(v.z) * gb[1]); o.w = pk2(bflo(v.w) * gb[2], bfhi(v.w) * gb[3]);
        *(uint4*)(sK + row * 72 + lch * 8) = o;
      }
    }
    __syncthreads();
#pragma unroll
    for (int ks = 0; ks < 2; ks++) {
      union { bf16x8 v; uint4 u4; } qf;
      qf.u4 = *(const uint4*)(xq + (size_t)tok * 1024 + h * 256 + dc * 64 + ks * 32 + q * 8);
      qss += bflo(qf.u4.x) * bflo(qf.u4.x) + bfhi(qf.u4.x) * bfhi(qf.u4.x) + bflo(qf.u4.y) * bflo(qf.u4.y) + bfhi(qf.u4.y) * bfhi(qf.u4.y)
           + bflo(qf.u4.z) * bflo(qf.u4.z) + bfhi(qf.u4.z) * bfhi(qf.u4.z) + bflo(qf.u4.w) * bflo(qf.u4.w) + bfhi(qf.u4.w) * bfhi(qf.u4.w);
#pragma unroll
      for (int kt = 0; kt < 16; kt++) {
        bf16x8 a = *(const bf16x8*)(sK + (kt * 16 + r) * 72 + ks * 32 + q * 8);
        s[kt] = __builtin_amdgcn_mfma_f32_16x16x32_bf16(a, qf.v, s[kt], 0, 0, 0);
      }
    }
  }
  qss += __shfl_xor(qss, 16); qss += __shfl_xor(qss, 32);
  float rq = rsqrtf(qss * (1.f / 256.f) + 1e-6f) * (1.f / 16.f);
  float mx = -1e30f;
#pragma unroll
  for (int kt = 0; kt < 16; kt++) {
    f32x4 rk4 = *(const f32x4*)(rkS + kt * 16 + q * 4);
    s[kt] = s[kt] * rq * rk4;
    mx = fmaxf(mx, fmaxf(fmaxf(s[kt][0], s[kt][1]), fmaxf(s[kt][2], s[kt][3])));
  }
  mx = fmaxf(mx, __shfl_xor(mx, 16)); mx = fmaxf(mx, __shfl_xor(mx, 32));
  float lsum = 0.f;
  bf16x8 pb[8];
#pragma unroll
  for (int i = 0; i < 8; i++) {
    union { bf16x8 v; unsigned u4[4]; } t;
#pragma unroll
    for (int hf = 0; hf < 2; hf++) {
      float p0 = __expf(s[2 * i + hf][0] - mx), p1 = __expf(s[2 * i + hf][1] - mx);
      float p2 = __expf(s[2 * i + hf][2] - mx), p3 = __expf(s[2 * i + hf][3] - mx);
      lsum += (p0 + p1) + (p2 + p3);
      t.u4[hf * 2] = pk2(p0, p1); t.u4[hf * 2 + 1] = pk2(p2, p3);
    }
    pb[i] = t.v;
  }
  lsum += __shfl_xor(lsum, 16); lsum += __shfl_xor(lsum, 32);
  float inv = 1.f / lsum;
#pragma unroll 1
  for (int dc = 0; dc < 4; dc++) {
    __syncthreads();
    {
      int row0 = tid >> 5, ch = tid & 31;
#pragma unroll
      for (int i = 0; i < 8; i++) {
        int row = row0 + 8 * i;
        uint4 v = *(const uint4*)(mvt + (((size_t)b * 4 + h) * 256 + dc * 64 + row) * 256 + ch * 8);
        *(uint4*)(sK + row * 264 + ch * 8) = v;
      }
    }
    __syncthreads();
    f32x4 o[4];
#pragma unroll
    for (int dt = 0; dt < 4; dt++) o[dt] = (f32x4){0.f, 0.f, 0.f, 0.f};
#pragma unroll
    for (int i = 0; i < 8; i++)
#pragma unroll
      for (int dt = 0; dt < 4; dt++) {
        const bf16_t* vp = sK + (dt * 16 + r) * 264 + 32 * i + 4 * q;
        union { bf16x8 v; uint2 u2[2]; } av;
        av.u2[0] = *(const uint2*)vp; av.u2[1] = *(const uint2*)(vp + 16);
        o[dt] = __builtin_amdgcn_mfma_f32_16x16x32_bf16(av.v, pb[i], o[dt], 0, 0, 0);
      }
#pragma unroll
    for (int dt = 0; dt < 4; dt++) {
      int d = dc * 64 + dt * 16 + q * 4;
      *(uint2*)(xo + (size_t)tok * 1024 + h * 256 + d) =
          make_uint2(pk2(o[dt][0] * inv, o[dt][1] * inv), pk2(o[dt][2] * inv, o[dt][3] * inv));
    }
  }
}


DI bool xcd_tile(int n, int bid, int G, int MT, int NT, int& mt, int& nt) {
  int NTG = (NT + 7) >> 3, MTG = (MT + 7) >> 3;
  int slots = G >> 3;
  int slot = bid >> 3, xcd = bid & 7;
  int per = (64 + slots - 1) / slots;
  int gi = n / per, sub = n % per;
  int g = gi * 8 + xcd;
  if (g >= NTG * MTG) return false;
  int s = slot + sub * slots;
  mt = -1; nt = 0;
  if (s < 64) {
    int mtg = g / NTG, ntg = g % NTG;
    int m_ = mtg * 8 + (s >> 3), n_ = ntg * 8 + (s & 7);
    if (m_ < MT && n_ < NT) { mt = m_; nt = n_; }
  }
  return true;
}

#define XB_TMO      128
#define XB_XCNT(j)  (256  + 64 * (j))
#define XB_XSUB(j)  (1280 + 64 * (j))
#define XB_XGEN(j)  (2304 + 64 * (j))
#define XB_TOP      3328
#define XB_TOPGEN   3392
#define XCD_BAR_WORDS 3456
#define XB_SPIN_CAP (1u << 18)
#define LAS __attribute__((address_space(3)))

__device__ __forceinline__ unsigned xb_ld(unsigned* p)              { return __hip_atomic_load(p, __ATOMIC_RELAXED, __HIP_MEMORY_SCOPE_AGENT); }
__device__ __forceinline__ unsigned xb_add(unsigned* p, unsigned v) { return __hip_atomic_fetch_add(p, v, __ATOMIC_RELAXED, __HIP_MEMORY_SCOPE_AGENT); }
__device__ __forceinline__ unsigned xb_xcc_id() { return (unsigned)__builtin_amdgcn_s_getreg((3 << 11) | 20) & 0xFu; }
#define XB_SPIN(cond, bar) do { unsigned _sp = 0; while (cond) { __builtin_amdgcn_s_sleep(1); \
    if ((++_sp & 255u) == 0u) { if (xb_ld(&(bar)[XB_TMO])) break; if (_sp > XB_SPIN_CAP) { atomicAdd(&(bar)[XB_TMO], 1u); break; } } } } while (0)

struct XcdBarrier {
    unsigned* bar; unsigned x;
    volatile LAS unsigned* st;
};

__device__ __forceinline__ XcdBarrier xcd_barrier_post(unsigned* bar, volatile LAS unsigned* st) {
    XcdBarrier b; b.bar = bar; b.x = xb_xcc_id(); b.st = st;
    if (threadIdx.x == 0) (void)xb_add(&bar[XB_XCNT(b.x)], 1u);
    return b;
}
__device__ __forceinline__ void xcd_barrier_complete(unsigned* bar, unsigned x, unsigned& nloc, unsigned& nx) {
    const unsigned G = gridDim.x * gridDim.y * gridDim.z;
    unsigned sum, cnt, mine, sp = 0u;
    for (;;) {
        sum = 0u; cnt = 0u; mine = 0u;
#pragma unroll
        for (unsigned j = 0; j < 16; ++j) { const unsigned c = xb_ld(&bar[XB_XCNT(j)]); sum += c; cnt += (c > 0u) ? 1u : 0u; mine = (j == x) ? c : mine; }
        if (sum == G) break;
        __builtin_amdgcn_s_sleep(1);
        if ((++sp & 255u) == 0u) { if (xb_ld(&bar[XB_TMO])) break; if (sp > XB_SPIN_CAP) { atomicAdd(&bar[XB_TMO], 1u); break; } }
    }
    nloc = mine > 0u ? mine : 1u; nx = cnt > 0u ? cnt : 1u;
}

__device__ __forceinline__ void xcd_barrier(const XcdBarrier& b) {
    asm volatile("s_waitcnt vmcnt(0)" ::: "memory");
    __syncthreads();
    if (threadIdx.x == 0) {
        unsigned* bar = b.bar;
        __builtin_amdgcn_s_waitcnt(0);
        unsigned nloc = b.st[0], nx = b.st[1];
        if (nloc == 0u) { xcd_barrier_complete(bar, b.x, nloc, nx); b.st[0] = nloc; b.st[1] = nx; }
        const unsigned old = xb_add(&bar[XB_XSUB(b.x)], 1u);
        const unsigned gen = old / nloc;
        if (old + 1u == (gen + 1u) * nloc) {
            __builtin_amdgcn_fence(__ATOMIC_RELEASE, "agent");
            asm volatile("s_waitcnt vmcnt(0)" ::: "memory");
            const unsigned og = xb_add(&bar[XB_TOP], 1u);
            const unsigned tg = og / nx;
            if (og + 1u == (tg + 1u) * nx) xb_add(&bar[XB_TOPGEN], 1u);
            else XB_SPIN(xb_ld(&bar[XB_TOPGEN]) == tg, bar);
            __builtin_amdgcn_fence(__ATOMIC_ACQUIRE, "");
            xb_add(&bar[XB_XGEN(b.x)], 1u);
            asm volatile("s_waitcnt vmcnt(0)" ::: "memory");
        } else {
            XB_SPIN(xb_ld(&bar[XB_XGEN(b.x)]) == gen, bar);
            __builtin_amdgcn_fence(__ATOMIC_ACQUIRE, "");
            asm volatile("s_waitcnt vmcnt(0)" ::: "memory");
        }
    }
    __syncthreads();
}


#define OPQ(x) ({ int _t = (x); asm volatile("" : "+s"(_t)); _t; })
#ifndef DUP_P1
#define DUP_P1 0
#endif
#ifndef DUP_P2a
#define DUP_P2a 0
#endif
#ifndef DUP_P2b
#define DUP_P2b 0
#endif
#ifndef DUP_P2c
#define DUP_P2c 0
#endif
#ifndef DUP_P4
#define DUP_P4 0
#endif
#ifndef DUP_P5
#define DUP_P5 0
#endif
#ifndef DUP_P6
#define DUP_P6 0
#endif
#ifndef DUP_P7
#define DUP_P7 0
#endif
#ifndef DUP_P8
#define DUP_P8 0
#endif
#ifndef DUP_P9
#define DUP_P9 0
#endif
#ifndef DUP_P10
#define DUP_P10 0
#endif
__global__ void __launch_bounds__(256, 2) fwd_megakernel(Params Parg) {
  __shared__ __attribute__((aligned(16))) unsigned char smem[57344];
  cg::grid_group grid = cg::this_grid();
  const int G = gridDim.x, bid = blockIdx.x;
  PPtr Pk = (PPtr)__builtin_amdgcn_kernarg_segment_ptr();
#define P (*launder_p(Pk))
#define ws (P.ws)

  __shared__ uint4 xb_words;
  if (threadIdx.x == 0) xb_words = make_uint4(0u, 0u, 0u, 0u);
  __syncthreads();
  XcdBarrier xb = xcd_barrier_post((unsigned*)(ws + OFF_BAR), (volatile LAS unsigned*)&xb_words);
  for (int it = bid; it < 1760; it += G) wconv_job(P, it, smem);
  phase0(P, smem);
  for (int it = 1760 + bid; it < NWCONV; it += G) wconv_job(P, it, smem);
  xcd_barrier(xb);
  xcd_barrier(xb);
  const int probe_nd = *(volatile const int*)(ws + OFF_PROBE);
  if (probe_nd < 0) grid.sync();
#ifdef DUP_SYNC
  for (int i = 0; i < 20; i++) grid.sync();
#endif

#pragma unroll 1
  for (int l = 0; l < 2; l++) {
    const float* hsrc = l == 0 ? P.in[0] : P.out;
    const bf16_t* wbl = (const bf16_t*)P.out + (size_t)OPQ(l) * WO_LAYER;
    for (int rep = 0; rep < 1 + DUP_P1; rep++) {
      for (int it = bid; it < 512; it += G) hy_spectra_job(P, OPQ(l), it, smem);
      int mt, nt;
      for (int n = 0; xcd_tile(n, bid, G, 128, 31, mt, nt); n++) if (mt >= 0) inproj_tile(P, OPQ(l), hsrc, mt, nt, smem);
    }
    xcd_barrier(xb);
    for (int rep = 0; rep < 1 + DUP_P2a; rep++) for (int it = bid; it < 1024 + 1024 + 256; it += G) {
      if (it < 1024) attn_unit(P, it, smem);
      else if (it < 2048) gla_state_unit(P, OPQ(l), it - 1024, smem);
      else { int t = it - 2048; memkv_tile(P, OPQ(l), t >> 4, t & 15, smem); }
    }
    xcd_barrier(xb);
    for (int rep = 0; rep < 1 + DUP_P2b; rep++) for (int it = bid; it < 512 + 2048; it += G) {
      if (it < 512) gla_scan_unit(P, it, (rep < DUP_P2b * probe_nd));
      else { int t = it - 512; hy_conv_job(P, OPQ(l), t >> 2, t & 3, smem, (rep < DUP_P2b * probe_nd)); }
    }
    xcd_barrier(xb);
    for (int rep = 0; rep < 1 + DUP_P2c; rep++) for (int it = bid; it < 1024; it += G) gla_out_unit(P, OPQ(l), it, smem, (rep < DUP_P2c * probe_nd));
    xcd_barrier(xb);
    for (int rep = 0; rep < 1 + DUP_P4; rep++) { int mt, nt; for (int n = 0; xcd_tile(n, bid, G, 128, 8, mt, nt); n++) if (mt >= 0) merge_tile(P, OPQ(l), hsrc, mt, nt, smem); }
    xcd_barrier(xb);
    for (int rep = 0; rep < 1 + DUP_P5; rep++) { int mt, nt; for (int n = 0; xcd_tile(n, bid, G, 64, 8, mt, nt); n++) if (mt >= 0)
      resid_tile256(P, (const bf16_t*)(ws + OFF_MIXED), 1024, 1024, wbl + WO_WOUT, false, mt, nt, smem, (rep < DUP_P5 * probe_nd)); }
    xcd_barrier(xb);
    for (int rep = 0; rep < 1 + DUP_P6; rep++) { int mt, nt; for (int n = 0; xcd_tile(n, bid, G, 64, 8, mt, nt); n++) if (mt >= 0)
      normed_tile256(P, wbl + WO_WQ, (bf16_t*)(ws + OFF_XQ), 1024, 0, mt, nt, smem); }
    xcd_barrier(xb);
    for (int rep = 0; rep < 1 + DUP_P7; rep++) for (int it = bid; it < 1024; it += G) xattn_unit(P, OPQ(l), it, smem);
    xcd_barrier(xb);
    for (int rep = 0; rep < 1 + DUP_P8; rep++) { int mt, nt; for (int n = 0; xcd_tile(n, bid, G, 64, 8, mt, nt); n++) if (mt >= 0)
      resid_tile256(P, (const bf16_t*)(ws + OFF_XO), 1024, 1024, wbl + WO_WO, false, mt, nt, smem, (rep < DUP_P8 * probe_nd)); }
    xcd_barrier(xb);
    for (int rep = 0; rep < 1 + DUP_P9; rep++) { int mt, nt; for (int n = 0; xcd_tile(n, bid, G, 64, 32, mt, nt); n++) if (mt >= 0)
      normed_tile256(P, wbl + WO_W1, (bf16_t*)(ws + OFF_HID), 4096, 1, mt, nt, smem); }
    xcd_barrier(xb);
    for (int rep = 0; rep < 1 + DUP_P10; rep++) { int mt, nt; for (int n = 0; xcd_tile(n, bid, G, 64, 8, mt, nt); n++) if (mt >= 0)
      resid_tile256(P, (const bf16_t*)(ws + OFF_HID), 4096, 4096, (l == 0 ? wbl + WO_W2 : (const bf16_t*)(ws + OFF_WB) + WS_W2L1), l == 1, mt, nt, smem, (rep < DUP_P10 * probe_nd)); }
    xcd_barrier(xb);
  }
}
#undef P
#undef ws

extern "C" void kernel_launch(void* const* d_in, const int* in_sizes, int n_in, void* d_out, int out_size, void* d_ws,
                              size_t ws_size, hipStream_t stream) {
  static int grid_blocks = 0;
  if (!grid_blocks) {
    int dev = 0, cus = 0, per_cu = 0;
    hipGetDevice(&dev);
    hipDeviceGetAttribute(&cus, hipDeviceAttributeMultiprocessorCount, dev);
    hipOccupancyMaxActiveBlocksPerMultiprocessor(&per_cu, fwd_megakernel, 256, 0);
    if (per_cu > 2) per_cu = 2;
    if (per_cu < 1) per_cu = 1;
    grid_blocks = cus * per_cu;
  }
  Params p{};
  for (int i = 0; i < 33; i++) p.in[i] = (const float*)d_in[i];
  p.out = (float*)d_out;
  p.ws = (unsigned char*)d_ws;
  (void)hipMemsetAsync((unsigned char*)d_ws + OFF_BAR, 0, 16384, stream);
  void* args[] = {&p};
  hipError_t e = hipLaunchCooperativeKernel((void*)fwd_megakernel, dim3(grid_blocks), dim3(256), args, 0, stream);
  if (e != hipSuccess) fprintf(stderr, "cooperative launch failed: %s (grid %d)\n", hipGetErrorString(e), grid_blocks);
}
```
